# Optimizing an MI355X kernel written in HIP

```python
import jax, jax.numpy as jnp
from jax import lax
import numpy as np

D_MODEL = 4096
BATCH = 4
SEQ = 2048
DEPTH = 1

CONV_WIDTH = D_MODEL
CONV_K = 3
SSM_EXPAND = 2
SSM_D_INNER = SSM_EXPAND * D_MODEL
SSM_HEAD_DIM = 64
SSM_N_HEADS = SSM_D_INNER // SSM_HEAD_DIM
SSM_N_GROUPS = 8
SSM_D_STATE = 128
SSM_CONV_K = 4
SSM_CHUNK = 128
SSM_CONV_DIM = SSM_D_INNER + 2 * SSM_N_GROUPS * SSM_D_STATE
D_FF = 11008
FFN_RESIDUAL_SCALE = 0.5
RMS_EPS = 1e-5

IN_SPLITS = (CONV_WIDTH, CONV_WIDTH, CONV_WIDTH,
             SSM_D_INNER,
             SSM_CONV_DIM,
             SSM_N_HEADS,
             D_MODEL, D_MODEL)
D_IN_PROJ = CONV_WIDTH * 3 + SSM_D_INNER + SSM_CONV_DIM + SSM_N_HEADS + 2 * D_MODEL

kernel_name = "hybrid_conv_ssd_gated_macaron"


def _split_cols(t, sizes):
    out, start = [], 0
    for s in sizes:
        out.append(t[..., start:start + s])
        start += s
    return out


def _rmsnorm(x, w):
    x32 = x.astype(jnp.float32)
    y = x32 * lax.rsqrt(jnp.mean(x32 * x32, axis=-1, keepdims=True) + RMS_EPS)
    return (y * w.astype(jnp.float32)).astype(x.dtype)


def _swiglu(h, w_gate, w_up, w_down):
    return (jax.nn.silu(h @ w_gate) * (h @ w_up)) @ w_down


def _causal_depthwise_conv(u, w):
    k_taps = w.shape[0]
    length = u.shape[1]
    up = jnp.pad(u, ((0, 0), (k_taps - 1, 0), (0, 0)))
    y = up[:, 0:length] * w[0]
    for k in range(1, k_taps):
        y = y + up[:, k:k + length] * w[k]
    return y


def _ssd_chunked(xs, dt, a_neg, bm, cm):
    b, l, h, p = xs.shape
    g, n = bm.shape[2], bm.shape[3]
    r = h // g
    c = l // SSM_CHUNK
    T = SSM_CHUNK
    xdt = (xs * dt[..., None]).reshape(b, c, T, g, r, p)
    a = (dt * a_neg).reshape(b, c, T, g, r)
    a_cs = jnp.cumsum(a, axis=2)
    bc = bm.reshape(b, c, T, g, n)
    cc = cm.reshape(b, c, T, g, n)

    a_t = jnp.transpose(a_cs, (0, 1, 3, 4, 2))
    seg = a_t[..., :, None] - a_t[..., None, :]
    causal = jnp.tril(jnp.ones((T, T), dtype=bool))
    lmat = jnp.exp(jnp.where(causal, seg, -jnp.inf))
    cb = jnp.einsum('bcign,bcjgn->bcgij', cc, bc)
    scores = cb[:, :, :, None] * lmat
    y_diag = jnp.einsum('bcgrij,bcjgrp->bcigrp', scores, xdt)

    decay_to_end = jnp.exp(a_cs[:, :, -1:] - a_cs)
    states = jnp.einsum('bcjgn,bcjgrp->bcgrpn', bc, xdt * decay_to_end[..., None])

    chunk_decay = jnp.exp(a_cs[:, :, -1])

    def step(carry, inp):
        s_c, d_c = inp
        new = d_c[..., None, None] * carry + s_c
        return new, carry

    init = jnp.zeros((b, g, r, p, n), dtype=xs.dtype)
    _, prev_states = lax.scan(step, init, (jnp.moveaxis(states, 1, 0), jnp.moveaxis(chunk_decay, 1, 0)))
    prev_states = jnp.moveaxis(prev_states, 0, 1)

    y_off = jnp.einsum('bcign,bcgrpn->bcigrp', cc, prev_states) * jnp.exp(a_cs)[..., None]
    return (y_diag + y_off).reshape(b, l, h, p)


def _mixer_block(h, w_in, gate_bias, sconv_w, sconv_w_out, ssm_conv_w, ssm_conv_b,
                 ssm_dt_bias, ssm_A_log, ssm_D, ssm_norm, ssm_w_out, w_o):
    bsz, length, _ = h.shape
    proj = jnp.einsum('bld,de->ble', h, w_in)
    c_b, c_c, c_x, z, xbc, dt_raw, g_a, g_b = _split_cols(proj, IN_SPLITS)

    y_a = (c_b * _causal_depthwise_conv(c_c * c_x, sconv_w)) @ sconv_w_out

    xbc = jax.nn.silu(_causal_depthwise_conv(xbc, ssm_conv_w) + ssm_conv_b)
    xs, bm, cm = _split_cols(xbc, (SSM_D_INNER, SSM_N_GROUPS * SSM_D_STATE, SSM_N_GROUPS * SSM_D_STATE))
    xs = xs.reshape(bsz, length, SSM_N_HEADS, SSM_HEAD_DIM).astype(jnp.float32)
    bm = bm.reshape(bsz, length, SSM_N_GROUPS, SSM_D_STATE).astype(jnp.float32)
    cm = cm.reshape(bsz, length, SSM_N_GROUPS, SSM_D_STATE).astype(jnp.float32)
    dt = jax.nn.softplus(dt_raw.astype(jnp.float32) + ssm_dt_bias.astype(jnp.float32))
    a_neg = -jnp.exp(ssm_A_log.astype(jnp.float32))
    y = _ssd_chunked(xs, dt, a_neg, bm, cm) + ssm_D.astype(jnp.float32)[:, None] * xs
    y = y.reshape(bsz, length, SSM_D_INNER) * jax.nn.silu(z.astype(jnp.float32))
    yg = y.reshape(bsz, length, SSM_N_GROUPS, SSM_D_INNER // SSM_N_GROUPS)
    yg = yg * lax.rsqrt(jnp.mean(yg * yg, axis=-1, keepdims=True) + RMS_EPS)
    y = (yg.reshape(bsz, length, SSM_D_INNER) * ssm_norm.astype(jnp.float32)).astype(h.dtype)
    y_b = y @ ssm_w_out

    gates = jax.nn.sigmoid(jnp.concatenate([g_a, g_b], axis=-1) + gate_bias)
    gate_a, gate_b = _split_cols(gates, (D_MODEL, D_MODEL))
    return (gate_a * y_a + gate_b * y_b) @ w_o


def setup_inputs(seed: int = 0) -> dict:
    key = jax.random.key(seed)
    ks = jax.random.split(key, 24)
    f32 = jnp.float32
    nrm = lambda k, shape, scale: jax.random.normal(k, shape, f32) * scale
    gain = lambda k, shape: 1.0 + 0.02 * jax.random.normal(k, shape, f32)
    L = DEPTH
    dt_init = jnp.exp(jax.random.uniform(ks[11], (L, SSM_N_HEADS), f32, np.log(1e-3), np.log(1e-1)))
    return {
        "x": jax.random.normal(ks[0], (BATCH, SEQ, D_MODEL), f32),
        "ffn1_norm": gain(ks[1], (L, D_MODEL)),
        "ffn1_w_gate": nrm(ks[2], (L, D_MODEL, D_FF), D_MODEL ** -0.5),
        "ffn1_w_up": nrm(ks[3], (L, D_MODEL, D_FF), D_MODEL ** -0.5),
        "ffn1_w_down": nrm(ks[4], (L, D_FF, D_MODEL), D_FF ** -0.5),
        "mix_norm": gain(ks[5], (L, D_MODEL)),
        "w_in": nrm(ks[6], (L, D_MODEL, D_IN_PROJ), D_MODEL ** -0.5),
        "gate_bias": nrm(ks[7], (L, 2 * D_MODEL), 0.01),
        "sconv_w": nrm(ks[8], (L, CONV_K, CONV_WIDTH), CONV_K ** -0.5),
        "sconv_w_out": nrm(ks[9], (L, CONV_WIDTH, D_MODEL), CONV_WIDTH ** -0.5),
        "ssm_conv_w": nrm(ks[10], (L, SSM_CONV_K, SSM_CONV_DIM), SSM_CONV_K ** -0.5),
        "ssm_conv_b": nrm(ks[12], (L, SSM_CONV_DIM), 0.01),
        "ssm_dt_bias": dt_init + jnp.log(-jnp.expm1(-dt_init)),
        "ssm_A_log": jnp.log(jax.random.uniform(ks[13], (L, SSM_N_HEADS), f32, 1.0, 16.0)),
        "ssm_D": 1.0 + 0.1 * jax.random.normal(ks[14], (L, SSM_N_HEADS), f32),
        "ssm_norm": gain(ks[15], (L, SSM_D_INNER)),
        "ssm_w_out": nrm(ks[16], (L, SSM_D_INNER, D_MODEL), SSM_D_INNER ** -0.5),
        "w_o": nrm(ks[17], (L, D_MODEL, D_MODEL), D_MODEL ** -0.5),
        "ffn2_norm": gain(ks[18], (L, D_MODEL)),
        "ffn2_w_gate": nrm(ks[19], (L, D_MODEL, D_FF), D_MODEL ** -0.5),
        "ffn2_w_up": nrm(ks[20], (L, D_MODEL, D_FF), D_MODEL ** -0.5),
        "ffn2_w_down": nrm(ks[21], (L, D_FF, D_MODEL), D_FF ** -0.5),
        "final_norm": gain(ks[22], (D_MODEL,)),
    }


def reference(x, ffn1_norm, ffn1_w_gate, ffn1_w_up, ffn1_w_down, mix_norm, w_in, gate_bias,
              sconv_w, sconv_w_out, ssm_conv_w, ssm_conv_b, ssm_dt_bias, ssm_A_log, ssm_D,
              ssm_norm, ssm_w_out, w_o, ffn2_norm, ffn2_w_gate, ffn2_w_up, ffn2_w_down,
              final_norm):
    for i in range(DEPTH):
        x = x + FFN_RESIDUAL_SCALE * _swiglu(_rmsnorm(x, ffn1_norm[i]), ffn1_w_gate[i], ffn1_w_up[i], ffn1_w_down[i])
        h = _rmsnorm(x, mix_norm[i])
        x = x + _mixer_block(h, w_in[i], gate_bias[i], sconv_w[i], sconv_w_out[i], ssm_conv_w[i],
                             ssm_conv_b[i], ssm_dt_bias[i], ssm_A_log[i], ssm_D[i], ssm_norm[i],
                             ssm_w_out[i], w_o[i])
        x = x + FFN_RESIDUAL_SCALE * _swiglu(_rmsnorm(x, ffn2_norm[i]), ffn2_w_gate[i], ffn2_w_up[i], ffn2_w_down[i])
    return _rmsnorm(x, final_norm)
```

```cpp
#include <hip/hip_runtime.h>
#include <cstdio>
#include <cstdint>
namespace pg8 {
#define PG8_LAS __attribute__((address_space(3)))
typedef unsigned short bf16_t;
typedef short bf16x8 __attribute__((ext_vector_type(8)));
typedef float f32x4 __attribute__((ext_vector_type(4)));
typedef unsigned u32x4 __attribute__((ext_vector_type(4)));
constexpr int BM = 256, BK = 64, HALF = 128, HTB = HALF * BK * 2  , STAGE_BYTES = 8 * HTB, NXCD = 8, WGM = 8;

__host__ __device__ __forceinline__ int lds_byte(int r, int c) { const int st = (r >> 4) * 2 + (c >> 5), rr = r & 15, cc = c & 31, ob = rr * 64 + cc * 2; return st * 1024 + (ob ^ (((ob >> 9) & 1) << 5)); }
__host__ __device__ __forceinline__ void stage_rc(int b, int& R, int& C) { const int st = b / 1024, sb = b % 1024, swz = sb ^ (((sb >> 9) & 1) << 5); R = (st >> 1) * 16 + swz / 64; C = (st & 1) * 32 + (swz % 64) / 2; }
__host__ __device__ __forceinline__ int perm32(int rho) { const int n = rho >> 4, i = rho & 15; return 8 * (i >> 2) + 4 * n + (i & 3); }

struct Unit { int pm, pn; };
struct Gemm { const bf16_t* A; const bf16_t* Bt; int M, N, K; };

struct StaticOrder {
    int nM, nN, nwg, G, c;
    __host__ __device__ void init(int M, int N, int G_, int c_) { nM = M / BM; nN = N / BM; nwg = nM * nN; G = G_; c = c_; }
    __host__ __device__ bool next(int i, Unit& u) const {
        const long L = (long)i * G + c; if (L >= nwg) return false;
        int wgid = (int)L; { const int q = nwg / NXCD, r = nwg % NXCD, xcd = wgid % NXCD, off = wgid / NXCD; wgid = (xcd < r ? xcd * (q + 1) : r * (q + 1) + (xcd - r) * q) + off; }
        const int nig = WGM * nN, gid = wgid / nig, fm = gid * WGM, gsz = (nM - fm) < WGM ? (nM - fm) : WGM;
        u.pm = fm + ((wgid % nig) % gsz); u.pn = (wgid % nig) / gsz; return true;
    }
    __device__ __forceinline__ void a_ready(const Unit&) const {}
    __device__ __forceinline__ void done(const Unit&) const {}
};

__device__ __forceinline__ unsigned cvt_pk_bf16(float lo, float hi) { unsigned r; asm volatile("v_cvt_pk_bf16_f32 %0, %1, %2" : "=v"(r) : "v"(lo), "v"(hi)); return r; }
typedef float f32x2 __attribute__((ext_vector_type(2)));

constexpr float RSQ_SCALE = 16777216.0f, RSQ_INV = 1.0f / 16777216.0f;
__device__ __forceinline__ unsigned long long rsq_fix(float s) { return (unsigned long long)(s * RSQ_SCALE + 0.5f); }
__device__ __forceinline__ float rstd_of(const unsigned long long* rsq, int row, float inv_n, float eps) {
    const unsigned long long v = rsq[row]; return __builtin_amdgcn_rsqf((float)v * (RSQ_INV * inv_n) + eps); }
__device__ __forceinline__ float fast_sigmoid(float v) { return __builtin_amdgcn_rcpf(1.0f + __builtin_amdgcn_exp2f(v * -1.44269504089f)); }
__device__ __forceinline__ float fast_silu(float v) { return v * fast_sigmoid(v); }
__device__ __forceinline__ u32x4 pack8(const f32x4 a, const f32x4 b) { u32x4 w; w.x = cvt_pk_bf16(a[0], a[1]); w.y = cvt_pk_bf16(a[2], a[3]); w.z = cvt_pk_bf16(b[0], b[1]); w.w = cvt_pk_bf16(b[2], b[3]); return w; }
__device__ __forceinline__ void unpack8(const u32x4 w, f32x4& a, f32x4& b) {
    a[0] = __uint_as_float(w.x << 16); a[1] = __uint_as_float(w.x & 0xffff0000u); a[2] = __uint_as_float(w.y << 16); a[3] = __uint_as_float(w.y & 0xffff0000u);
    b[0] = __uint_as_float(w.z << 16); b[1] = __uint_as_float(w.z & 0xffff0000u); b[2] = __uint_as_float(w.w << 16); b[3] = __uint_as_float(w.w & 0xffff0000u); }
constexpr float RMS_EPS_F = 1e-5f;

struct EpiGateUp {
    static constexpr bool PERM = true, AFTER_DRAIN = false;
    bf16_t* O; int ldc; const unsigned long long* rsq; float inv_n;
    __device__ __forceinline__ void operator()(const f32x4 (&acc)[2][2][4][2], const Unit& u, int wr, int wc, int fr, int fq) const {
        const int row0 = u.pm * BM + wr * 64 + fr, col0 = u.pn * HALF + wc * 32 + 8 * fq;
#pragma unroll
        for (int ai = 0; ai < 2; ++ai)
#pragma unroll
            for (int m = 0; m < 4; ++m) { const int row = row0 + ai * HALF + m * 16; const float rs = rstd_of(rsq, row, inv_n, RMS_EPS_F);
                f32x4 o[2];
#pragma unroll
                for (int n = 0; n < 2; ++n)
#pragma unroll
                    for (int j = 0; j < 4; ++j) o[n][j] = fast_silu(acc[ai][0][m][n][j] * rs) * (acc[ai][1][m][n][j] * rs);
                *(u32x4*)(O + (size_t)row * ldc + col0) = pack8(o[0], o[1]); }
    }
};
template <bool WITH_HB> struct EpiResid {
    static constexpr bool PERM = true, AFTER_DRAIN = false;
    const float* base; float* out; bf16_t* hb; unsigned long long* rsq_out; float scale; int ldc;
    __device__ __forceinline__ void operator()(const f32x4 (&acc)[2][2][4][2], const Unit& u, int wr, int wc, int fr, int fq) const {
        const int row0 = u.pm * BM + wr * 64 + fr, col0 = u.pn * BM + wc * 32 + 8 * fq;
#pragma unroll
        for (int ai = 0; ai < 2; ++ai)
#pragma unroll
            for (int m = 0; m < 4; ++m) { const int row = row0 + ai * HALF + m * 16; const size_t off = (size_t)row * ldc + col0; float ss = 0.f;
#pragma unroll
                for (int bj = 0; bj < 2; ++bj) {
                    const f32x4 b0 = *(const f32x4*)(base + off + bj * HALF), b1 = *(const f32x4*)(base + off + bj * HALF + 4);
                    const f32x4 v0 = b0 + acc[ai][bj][m][0] * scale, v1 = b1 + acc[ai][bj][m][1] * scale;
                    *(f32x4*)(out + off + bj * HALF) = v0; *(f32x4*)(out + off + bj * HALF + 4) = v1;
                    if (WITH_HB) *(u32x4*)(hb + off + bj * HALF) = pack8(v0, v1);
                    ss += (v0[0] * v0[0] + v0[1] * v0[1]) + (v0[2] * v0[2] + v0[3] * v0[3]) + (v1[0] * v1[0] + v1[1] * v1[1]) + (v1[2] * v1[2] + v1[3] * v1[3]); }
                ss += __shfl_xor(ss, 16); ss += __shfl_xor(ss, 32);
                if (fq == 0) atomicAdd(rsq_out + row, rsq_fix(ss));
                asm volatile("" ::: "memory"); }
    }
};
struct EpiProj {
    static constexpr bool PERM = true, AFTER_DRAIN = false;
    bf16_t *CB, *U, *Z, *XBC, *GA, *GB; float* DT; const float* gbias; const float* dtbias; const unsigned long long* rsq; float inv_n;
    template <int ACT  >
    __device__ __forceinline__ void plain(const f32x4 (&acc)[2][2][4][2], bf16_t* O, int ldc, int colt, const float* bias, int row0, int wc, int fq) const {
        const int col0 = colt + wc * 32 + 8 * fq;
        f32x4 bv[2][2];
#pragma unroll
        for (int bj = 0; bj < 2; ++bj)
#pragma unroll
            for (int n = 0; n < 2; ++n) bv[bj][n] = (ACT == 2) ? *(const f32x4*)(bias + col0 + bj * HALF + 4 * n) : (f32x4){0.f, 0.f, 0.f, 0.f};
#pragma unroll
        for (int ai = 0; ai < 2; ++ai)
#pragma unroll
            for (int m = 0; m < 4; ++m) { const int row = row0 + ai * HALF + m * 16; const float rs = rstd_of(rsq, row, inv_n, RMS_EPS_F);
#pragma unroll
                for (int bj = 0; bj < 2; ++bj) { f32x4 o[2];
#pragma unroll
                    for (int n = 0; n < 2; ++n)
#pragma unroll
                        for (int j = 0; j < 4; ++j) { const float v = acc[ai][bj][m][n][j] * rs; o[n][j] = (ACT == 0) ? v : (ACT == 1) ? fast_silu(v) : fast_sigmoid(v + bv[bj][n][j]); }
                    *(u32x4*)(O + (size_t)row * ldc + col0 + bj * HALF) = pack8(o[0], o[1]); } }
    }
    __device__ __forceinline__ void operator()(const f32x4 (&acc)[2][2][4][2], const Unit& u, int wr, int wc, int fr, int fq) const {
        const int row0 = u.pm * BM + wr * 64 + fr, pn = u.pn;
        if (pn < 16) plain<0>(acc, CB, 4096, pn * BM, nullptr, row0, wc, fq);
        else if (pn < 48) {
            const int col0 = (pn - 16) * HALF + wc * 32 + 8 * fq;
#pragma unroll
            for (int ai = 0; ai < 2; ++ai)
#pragma unroll
                for (int m = 0; m < 4; ++m) { const int row = row0 + ai * HALF + m * 16; const float rs = rstd_of(rsq, row, inv_n, RMS_EPS_F); const float rs2 = rs * rs;
                    f32x4 o[2];
#pragma unroll
                    for (int n = 0; n < 2; ++n) o[n] = (acc[ai][0][m][n] * acc[ai][1][m][n]) * rs2;
                    *(u32x4*)(U + (size_t)row * 4096 + col0) = pack8(o[0], o[1]); }
        }
        else if (pn < 80) plain<1>(acc, Z, 8192, (pn - 48) * BM, nullptr, row0, wc, fq);
        else if (pn < 120) plain<0>(acc, XBC, 10240, (pn - 80) * BM, nullptr, row0, wc, fq);
        else if (pn < 136) plain<2>(acc, GA, 4096, (pn - 120) * BM, gbias, row0, wc, fq);
        else if (pn < 152) plain<2>(acc, GB, 4096, (pn - 136) * BM, gbias + 4096, row0, wc, fq);
        else {
            const int col0 = wc * 32 + 8 * fq;
            f32x4 bv[2];
#pragma unroll
            for (int n = 0; n < 2; ++n) bv[n] = *(const f32x4*)(dtbias + col0 + 4 * n);
#pragma unroll
            for (int ai = 0; ai < 2; ++ai)
#pragma unroll
                for (int m = 0; m < 4; ++m) { const int row = row0 + ai * HALF + m * 16; const float rs = rstd_of(rsq, row, inv_n, RMS_EPS_F);
#pragma unroll
                    for (int n = 0; n < 2; ++n) { f32x4 o;
#pragma unroll
                        for (int j = 0; j < 4; ++j) { const float v = acc[ai][0][m][n][j] * rs + bv[n][j]; o[j] = fmaxf(v, 0.f) + log1pf(__expf(-fabsf(v))); }
                        *(f32x4*)(DT + (size_t)row * 128 + col0 + 4 * n) = o; } }
        }
    }
};
struct EpiScA {
    static constexpr bool PERM = true, AFTER_DRAIN = false;
    const bf16_t* GA; float* T;
    __device__ __forceinline__ void operator()(const f32x4 (&acc)[2][2][4][2], const Unit& u, int wr, int wc, int fr, int fq) const {
        const int row0 = u.pm * BM + wr * 64 + fr, col0 = u.pn * BM + wc * 32 + 8 * fq;
#pragma unroll
        for (int ai = 0; ai < 2; ++ai)
#pragma unroll
            for (int m = 0; m < 4; ++m) { const size_t off = (size_t)(row0 + ai * HALF + m * 16) * 4096 + col0;
#pragma unroll
                for (int bj = 0; bj < 2; ++bj) { f32x4 g0, g1; unpack8(*(const u32x4*)(GA + off + bj * HALF), g0, g1);
                    *(f32x4*)(T + off + bj * HALF) = g0 * acc[ai][bj][m][0]; *(f32x4*)(T + off + bj * HALF + 4) = g1 * acc[ai][bj][m][1]; }
                asm volatile("" ::: "memory"); }
    }
};
struct EpiSsB {
    static constexpr bool PERM = true, AFTER_DRAIN = false;
    const bf16_t* GB; const float* T; bf16_t* MIX;
    __device__ __forceinline__ void operator()(const f32x4 (&acc)[2][2][4][2], const Unit& u, int wr, int wc, int fr, int fq) const {
        const int row0 = u.pm * BM + wr * 64 + fr, col0 = u.pn * BM + wc * 32 + 8 * fq;
#pragma unroll
        for (int ai = 0; ai < 2; ++ai)
#pragma unroll
            for (int m = 0; m < 4; ++m) { const size_t off = (size_t)(row0 + ai * HALF + m * 16) * 4096 + col0;
#pragma unroll
                for (int bj = 0; bj < 2; ++bj) { f32x4 g0, g1; unpack8(*(const u32x4*)(GB + off + bj * HALF), g0, g1);
                    const f32x4 t0 = *(const f32x4*)(T + off + bj * HALF), t1 = *(const f32x4*)(T + off + bj * HALF + 4);
                    *(u32x4*)(MIX + off + bj * HALF) = pack8(t0 + g0 * acc[ai][bj][m][0], t1 + g1 * acc[ai][bj][m][1]); }
                asm volatile("" ::: "memory"); }
    }
};


template <class Epi, class Sched, bool ALIGN_EPI = false, bool SP2 = false>
__device__ __forceinline__ void gemm_phase(PG8_LAS unsigned char* lds, const Gemm g, const Sched& S, const Epi& E) {
    const int tid = threadIdx.x, wid = __builtin_amdgcn_readfirstlane(tid >> 6), lane = tid & 63, wr = wid >> 2, wc = wid & 3, fr = lane & 15, fq = lane >> 4;
    const int K = g.K, nt = K / BK;
    unsigned voffA[2], voffB[2];
#pragma unroll
    for (int i = 0; i < 2; ++i) { int R, C; stage_rc(tid * 16 + i * 8192, R, C); const int Rb = Epi::PERM ? ((R & ~31) + perm32(R & 31)) : R;
        voffA[i] = (unsigned)(R * K + C) * 2u; voffB[i] = (unsigned)(Rb * K + C) * 2u; }
    const size_t kstep = (size_t)(BK * 2);
    const size_t hstep = (size_t)HALF * K * 2;
    const size_t tstep = 2 * hstep;
    const unsigned ldsw = (unsigned)wid * 1024u;
    const int aoff = lds_byte(wr * 64 + fr, fq * 8), boff = lds_byte(wc * 32 + fr, fq * 8);
#define PG8_SA(b, h) (((b) * 2 + (h)) * HTB)
#define PG8_SB(b, h) ((4 + (b) * 2 + (h)) * HTB)
#define PG8_STAGE(bufoff, gbase, voff) do { _Pragma("unroll") for (int _i = 0; _i < 2; ++_i) \
        __builtin_amdgcn_global_load_lds((const unsigned*)((const char*)(gbase) + (voff)[_i]), (PG8_LAS unsigned*)(lds + (bufoff) + ldsw + _i * 8192), 16, 0, 0); } while (0)
#define PG8_LDA(dst, b, h) do { _Pragma("unroll") for (int m = 0; m < 4; ++m) _Pragma("unroll") for (int k = 0; k < 2; ++k) dst[m][k] = *(const PG8_LAS bf16x8*)(lds + PG8_SA(b, h) + aoff + m * 2048 + k * 1024); } while (0)
#define PG8_LDB(dst, b, h) do { _Pragma("unroll") for (int n = 0; n < 2; ++n) _Pragma("unroll") for (int k = 0; k < 2; ++k) dst[n][k] = *(const PG8_LAS bf16x8*)(lds + PG8_SB(b, h) + boff + n * 2048 + k * 1024); } while (0)
#define PG8_MMA(ai, bj, At, Bt) do { __builtin_amdgcn_s_setprio(1); _Pragma("unroll") for (int m = 0; m < 4; ++m) _Pragma("unroll") for (int n = 0; n < 2; ++n) _Pragma("unroll") for (int k = 0; k < 2; ++k) \
        acc[ai][bj][m][n] = __builtin_amdgcn_mfma_f32_16x16x32_bf16(Bt[n][k], At[m][k], acc[ai][bj][m][n], 0, 0, 0); __builtin_amdgcn_s_setprio(0); } while (0)
#define PG8_WAIT_V(n) asm volatile("s_waitcnt vmcnt(" #n ")" ::: "memory")
#define PG8_WAIT_L(n) asm volatile("s_waitcnt lgkmcnt(" #n ")" ::: "memory")
#define PG8_BAR __builtin_amdgcn_s_barrier()
#define PG8_SCHED __builtin_amdgcn_sched_barrier(0)
    Unit cur, nxt; int ui = 0;
    if (!S.next(0, cur)) return;
    f32x4 acc[2][2][4][2];
#pragma unroll
    for (int a = 0; a < 2; ++a)
#pragma unroll
        for (int b = 0; b < 2; ++b)
#pragma unroll
            for (int m = 0; m < 4; ++m)
#pragma unroll
                for (int n = 0; n < 2; ++n) acc[a][b][m][n] = (f32x4){0.f, 0.f, 0.f, 0.f};
    bf16x8 At[4][2], B0[2][2], B1[2][2];
    const char* cA = (const char*)g.A + (size_t)cur.pm * tstep; const char* cB = (const char*)g.Bt + (size_t)cur.pn * tstep;
    S.a_ready(cur);
    if constexpr (SP2) {
        PG8_STAGE(PG8_SB(0, 0), cB, voffB); PG8_STAGE(PG8_SB(0, 1), cB + hstep, voffB); PG8_STAGE(PG8_SA(0, 0), cA, voffA); PG8_STAGE(PG8_SA(0, 1), cA + hstep, voffA);
        if (wr == 1) PG8_BAR;
        PG8_WAIT_V(2); PG8_BAR;
        PG8_STAGE(PG8_SB(1, 0), cB + kstep, voffB); PG8_STAGE(PG8_SA(1, 0), cA + kstep, voffA); PG8_STAGE(PG8_SB(1, 1), cB + hstep + kstep, voffB);
        PG8_WAIT_V(6); PG8_BAR;
    } else {
        PG8_STAGE(PG8_SB(0, 0), cB, voffB); PG8_STAGE(PG8_SA(0, 0), cA, voffA); PG8_STAGE(PG8_SB(0, 1), cB + hstep, voffB); PG8_STAGE(PG8_SA(0, 1), cA + hstep, voffA);
        if (wr == 1) PG8_BAR;
        PG8_WAIT_V(4); PG8_BAR;
        PG8_STAGE(PG8_SB(1, 0), cB + kstep, voffB); PG8_STAGE(PG8_SA(1, 0), cA + kstep, voffA); PG8_STAGE(PG8_SB(1, 1), cB + hstep + kstep, voffB);
        PG8_WAIT_V(6); PG8_BAR;
    }
    for (;;) {
        const bool has_next = S.next(ui + 1, nxt);
        const char* nA = has_next ? (const char*)g.A + (size_t)nxt.pm * tstep : cA; const char* nB = has_next ? (const char*)g.Bt + (size_t)nxt.pn * tstep : cB;
        for (int t = 0; t < nt; t += 2) {
            const bool last = (t == nt - 2);
            const char* a1 = cA + (size_t)(t + 1) * kstep;
            const char* a2 = last ? nA : cA + (size_t)(t + 2) * kstep; const char* b2 = last ? nB : cB + (size_t)(t + 2) * kstep;
            const char* a3 = a2 + kstep; const char* b3 = b2 + kstep;
            if (last && has_next) S.a_ready(nxt);
            if constexpr (SP2) {
            PG8_LDB(B0, 0, 0); PG8_LDB(B1, 0, 1); PG8_SCHED; PG8_LDA(At, 0, 0); PG8_STAGE(PG8_SA(1, 1), a1 + hstep, voffA);
            PG8_WAIT_V(8); PG8_WAIT_L(0); PG8_BAR; PG8_MMA(0, 0, At, B0); PG8_MMA(0, 1, At, B1); PG8_BAR; PG8_SCHED;
            PG8_LDA(At, 0, 1); PG8_STAGE(PG8_SB(0, 0), b2, voffB); PG8_STAGE(PG8_SB(0, 1), b2 + hstep, voffB); PG8_STAGE(PG8_SA(0, 0), a2, voffA);
            PG8_WAIT_V(8); PG8_WAIT_L(0); PG8_BAR; PG8_MMA(1, 0, At, B0); PG8_MMA(1, 1, At, B1); PG8_BAR; PG8_SCHED;
            PG8_LDB(B0, 1, 0); PG8_LDB(B1, 1, 1); PG8_SCHED; PG8_LDA(At, 1, 0); PG8_STAGE(PG8_SA(0, 1), a2 + hstep, voffA);
            PG8_WAIT_V(8); PG8_WAIT_L(0); PG8_BAR; PG8_MMA(0, 0, At, B0); PG8_MMA(0, 1, At, B1); PG8_BAR; PG8_SCHED;
            PG8_LDA(At, 1, 1); PG8_STAGE(PG8_SB(1, 0), b3, voffB); PG8_STAGE(PG8_SB(1, 1), b3 + hstep, voffB); PG8_STAGE(PG8_SA(1, 0), a3, voffA);
            PG8_WAIT_V(8); PG8_WAIT_L(0); PG8_BAR; PG8_MMA(1, 0, At, B0); PG8_MMA(1, 1, At, B1); PG8_BAR; PG8_SCHED;
            } else {
            PG8_LDB(B0, 0, 0); PG8_SCHED; PG8_LDA(At, 0, 0); PG8_STAGE(PG8_SA(1, 1), a1 + hstep, voffA);
            PG8_WAIT_L(8); PG8_BAR; PG8_WAIT_L(0); PG8_MMA(0, 0, At, B0); PG8_BAR; PG8_SCHED;
            PG8_LDB(B1, 0, 1); PG8_STAGE(PG8_SB(0, 0), b2, voffB);
            PG8_BAR; PG8_WAIT_L(0); PG8_MMA(0, 1, At, B1); PG8_BAR;
            PG8_LDA(At, 0, 1); PG8_STAGE(PG8_SA(0, 0), a2, voffA);
            PG8_BAR; PG8_WAIT_L(0); PG8_MMA(1, 0, At, B0); PG8_BAR; PG8_SCHED;
            PG8_STAGE(PG8_SB(0, 1), b2 + hstep, voffB);
            PG8_WAIT_V(6); PG8_BAR; PG8_MMA(1, 1, At, B1); PG8_BAR;
            PG8_LDB(B0, 1, 0); PG8_SCHED; PG8_LDA(At, 1, 0); PG8_STAGE(PG8_SA(0, 1), a2 + hstep, voffA);
            PG8_WAIT_L(8); PG8_BAR; PG8_WAIT_L(0); PG8_MMA(0, 0, At, B0); PG8_BAR; PG8_SCHED;
            PG8_LDB(B1, 1, 1); PG8_STAGE(PG8_SB(1, 0), b3, voffB);
            PG8_BAR; PG8_WAIT_L(0); PG8_MMA(0, 1, At, B1); PG8_BAR;
            PG8_LDA(At, 1, 1); PG8_STAGE(PG8_SA(1, 0), a3, voffA);
            PG8_BAR; PG8_WAIT_L(0); PG8_MMA(1, 0, At, B0); PG8_BAR; PG8_SCHED;
            PG8_STAGE(PG8_SB(1, 1), b3 + hstep, voffB);
            PG8_WAIT_V(6); PG8_BAR; PG8_MMA(1, 1, At, B1); PG8_BAR;
            }
        }
        if constexpr (ALIGN_EPI) { if (wr == 0) PG8_BAR; }
        if constexpr (!Epi::AFTER_DRAIN) { E(acc, cur, wr, wc, fr, fq); S.done(cur); }
        if (!has_next) break;
#pragma unroll
        for (int a = 0; a < 2; ++a)
#pragma unroll
            for (int b = 0; b < 2; ++b)
#pragma unroll
                for (int m = 0; m < 4; ++m)
#pragma unroll
                    for (int n = 0; n < 2; ++n) acc[a][b][m][n] = (f32x4){0.f, 0.f, 0.f, 0.f};
        cur = nxt; cA = nA; cB = nB; ++ui;
        if constexpr (ALIGN_EPI) { if (wr == 1) PG8_BAR; }
    }
    PG8_WAIT_V(0);
    if constexpr (!ALIGN_EPI) { if (wr == 0) PG8_BAR; }
    PG8_BAR;
    if constexpr (Epi::AFTER_DRAIN) { E.fused(acc, cur, wr, wc, fr, fq, lds, wid, lane); S.done(cur); }
#undef PG8_SA
#undef PG8_SB
#undef PG8_STAGE
#undef PG8_LDA
#undef PG8_LDB
#undef PG8_MMA
#undef PG8_WAIT_V
#undef PG8_WAIT_L
#undef PG8_BAR
#undef PG8_SCHED
}
}

constexpr int NWAVES = 8;
#ifndef MK_N_LAUNCHES
#define MK_N_LAUNCHES 12
#endif
constexpr int NPHASE = 12;
constexpr int N_LAUNCHES = MK_N_LAUNCHES;
static_assert(N_LAUNCHES == 1 || N_LAUNCHES == NPHASE, "MK_N_LAUNCHES is 1 or NPHASE");
constexpr int BATCH = 4, SEQ = 2048, D = 4096, FF = 11008, DI = 8192, NH = 128, CONVDIM = 10240;
constexpr int M = BATCH * SEQ;
constexpr int NPROJ = 39040, NPROJ_PAD = 39168;

constexpr size_t MiB = 1u << 20;
constexpr size_t WS_CTL = 0, CTL_ZERO_BYTES = 2 * MiB;
constexpr size_t WS_RSQ = 1 * MiB;
constexpr size_t WS_WGU1 = 2 * MiB, WS_WD1 = WS_WGU1 + 172 * MiB, WS_WIN = WS_WD1 + 86 * MiB, WS_WSC = WS_WIN + 306 * MiB, WS_WSS = WS_WSC + 32 * MiB,
                 WS_WO = WS_WSS + 64 * MiB, WS_WGU2 = WS_WO + 32 * MiB, WS_WD2 = WS_WGU2 + 172 * MiB;
constexpr size_t WS_H = WS_WD2 + 86 * MiB, WS_ACT = WS_H + 64 * MiB, WS_CB = WS_ACT + 172 * MiB, WS_U = WS_CB + 64 * MiB, WS_Z = WS_U + 64 * MiB, WS_XBC = WS_Z + 128 * MiB,
                 WS_GA = WS_XBC + 160 * MiB, WS_GB = WS_GA + 64 * MiB, WS_DT = WS_GB + 64 * MiB, WS_AIN = WS_DT + 4 * MiB, WS_YG = WS_AIN + 64 * MiB, WS_T = WS_YG + 128 * MiB,
                 WS_MIX = WS_T + 128 * MiB, WS_END = WS_MIX + 64 * MiB;
static_assert((size_t)2 * FF * D * 2 == 172 * MiB && (size_t)D * FF * 2 == 86 * MiB && (size_t)NPROJ_PAD * D * 2 == 306 * MiB && (size_t)M * FF * 2 == 172 * MiB && (size_t)M * CONVDIM * 2 == 160 * MiB, "d_ws map");
static_assert(WS_RSQ + (size_t)4 * M * 8 + (size_t)M * 8 * 8 <= CTL_ZERO_BYTES, "row statistics inside the memset region");
static_assert(WS_END <= (size_t)2440 * MiB, "d_ws map exceeds 4 x the largest input");
constexpr int CW_BAR = 4096;

constexpr int RING_OFF = 0, RING_BYTES = 131072;
constexpr int LDSCTL_OFF = RING_BYTES, MISC_OFF = LDSCTL_OFF + 320;
constexpr int SSD_DD_OFF = RING_BYTES + 1024;
constexpr int LDS_BYTES = 147456;
static_assert(MISC_OFF + 128 <= SSD_DD_OFF && SSD_DD_OFF + 1024 <= LDS_BYTES, "LDS map");

#define GAS __attribute__((address_space(1)))
#define LAS __attribute__((address_space(3)))
typedef unsigned short bf16;
typedef unsigned v4u __attribute__((ext_vector_type(4)));
typedef float f32x4 __attribute__((ext_vector_type(4)));
typedef short bf16x8 __attribute__((ext_vector_type(8)));
typedef GAS unsigned gu32;
typedef GAS unsigned long long gu64;
#define RLX_AGENT __ATOMIC_RELAXED, __HIP_MEMORY_SCOPE_AGENT
#define LDS_WAIT() asm volatile("s_waitcnt lgkmcnt(0)" ::: "memory")
#define VM_WAIT() asm volatile("s_waitcnt vmcnt(0)" ::: "memory")
__device__ __forceinline__ unsigned long long rt() { return __builtin_amdgcn_s_memrealtime(); }
__device__ __forceinline__ unsigned f2bf(float f) { unsigned u = __builtin_bit_cast(unsigned, f); return (u + 0x7fffu + ((u >> 16) & 1u)) >> 16; }
__device__ __forceinline__ unsigned pk2(float lo, float hi) { return f2bf(lo) | (f2bf(hi) << 16); }
#define XB_TMO      128
#define XB_XCNT(j)  (256  + 64 * (j))
#define XB_XSUB(j)  (1280 + 64 * (j))
#define XB_XGEN(j)  (2304 + 64 * (j))
#define XB_TOP      3328
#define XB_TOPGEN   3392
#define XCD_BAR_WORDS 3456
#define XB_SPIN_CAP (1u << 18)

__device__ __forceinline__ unsigned xb_ld(unsigned* p)              { return __hip_atomic_load(p, __ATOMIC_RELAXED, __HIP_MEMORY_SCOPE_AGENT); }
__device__ __forceinline__ unsigned xb_add(unsigned* p, unsigned v) { return __hip_atomic_fetch_add(p, v, __ATOMIC_RELAXED, __HIP_MEMORY_SCOPE_AGENT); }
__device__ __forceinline__ unsigned xb_xcc_id() { return (unsigned)__builtin_amdgcn_s_getreg((3 << 11) | 20) & 0xFu; }
#define XB_SPIN(cond, bar) do { unsigned _sp = 0; while (cond) { __builtin_amdgcn_s_sleep(1); \
    if ((++_sp & 255u) == 0u) { if (xb_ld(&(bar)[XB_TMO])) break; if (_sp > XB_SPIN_CAP) { atomicAdd(&(bar)[XB_TMO], 1u); break; } } } } while (0)

struct XcdBarrier {
    unsigned* bar; unsigned x;
    volatile LAS unsigned* st;
};

__device__ __forceinline__ XcdBarrier xcd_barrier_post(unsigned* bar, volatile LAS unsigned* st) {
    XcdBarrier b; b.bar = bar; b.x = xb_xcc_id(); b.st = st;
    if (threadIdx.x == 0) (void)xb_add(&bar[XB_XCNT(b.x)], 1u);
    return b;
}
__device__ __forceinline__ void xcd_barrier_complete(unsigned* bar, unsigned x, unsigned& nloc, unsigned& nx) {
    const unsigned G = gridDim.x * gridDim.y * gridDim.z;
    unsigned sum, cnt, mine, sp = 0u;
    for (;;) {
        sum = 0u; cnt = 0u; mine = 0u;
#pragma unroll
        for (unsigned j = 0; j < 16; ++j) { const unsigned c = xb_ld(&bar[XB_XCNT(j)]); sum += c; cnt += (c > 0u) ? 1u : 0u; mine = (j == x) ? c : mine; }
        if (sum == G) break;
        __builtin_amdgcn_s_sleep(1);
        if ((++sp & 255u) == 0u) { if (xb_ld(&bar[XB_TMO])) break; if (sp > XB_SPIN_CAP) { atomicAdd(&bar[XB_TMO], 1u); break; } }
    }
    nloc = mine > 0u ? mine : 1u; nx = cnt > 0u ? cnt : 1u;
}

__device__ __forceinline__ void xcd_barrier(const XcdBarrier& b) {
    asm volatile("s_waitcnt vmcnt(0)" ::: "memory");
    __syncthreads();
    if (threadIdx.x == 0) {
        unsigned* bar = b.bar;
        __builtin_amdgcn_s_waitcnt(0);
        unsigned nloc = b.st[0], nx = b.st[1];
        if (nloc == 0u) { xcd_barrier_complete(bar, b.x, nloc, nx); b.st[0] = nloc; b.st[1] = nx; }
        const unsigned old = xb_add(&bar[XB_XSUB(b.x)], 1u);
        const unsigned gen = old / nloc;
        if (old + 1u == (gen + 1u) * nloc) {
            __builtin_amdgcn_fence(__ATOMIC_RELEASE, "agent");
            asm volatile("s_waitcnt vmcnt(0)" ::: "memory");
            const unsigned og = xb_add(&bar[XB_TOP], 1u);
            const unsigned tg = og / nx;
            if (og + 1u == (tg + 1u) * nx) xb_add(&bar[XB_TOPGEN], 1u);
            else XB_SPIN(xb_ld(&bar[XB_TOPGEN]) == tg, bar);
            __builtin_amdgcn_fence(__ATOMIC_ACQUIRE, "agent");
            xb_add(&bar[XB_XGEN(b.x)], 1u);
            asm volatile("s_waitcnt vmcnt(0)" ::: "memory");
        } else {
            XB_SPIN(xb_ld(&bar[XB_XGEN(b.x)]) == gen, bar);
            __builtin_amdgcn_fence(__ATOMIC_ACQUIRE, "agent");
            asm volatile("s_waitcnt vmcnt(0)" ::: "memory");
        }
    }
    __syncthreads();
}

struct Frame {
    LAS unsigned char* lds;
    volatile LAS unsigned* MISC;
    gu32* ctl;
    int tid, lane, wave;
    int vcu, G;
};
__device__ __forceinline__ float wave_sum(float v) {
#pragma unroll
    for (int o = 1; o < 64; o <<= 1) v += __shfl_xor(v, o);
    return v;
}
__device__ __forceinline__ float bf_lo(unsigned w) { return __uint_as_float(w << 16); }
__device__ __forceinline__ float bf_hi(unsigned w) { return __uint_as_float(w & 0xffff0000u); }

__device__ __forceinline__ void p0_transpose_item(const float* W, int ld, int c0, int K, bf16* WT, int drow0, const float* nw, LAS float* scr, int kb, int lane) {
    const int k0 = 64 * kb;
#pragma unroll 8
    for (int i = 0; i < 32; ++i) { const int kk = 2 * i + (lane >> 5); float v = W[(size_t)(k0 + kk) * ld + c0 + (lane & 31)]; if (nw) v *= nw[k0 + kk]; scr[kk * 33 + (lane & 31)] = v; }
    LDS_WAIT(); asm volatile("" ::: "memory");
    const int c = lane & 7;
#pragma unroll
    for (int j = 0; j < 4; ++j) { const int n = (lane >> 3) + 8 * j; const LAS float* s = scr + (8 * c) * 33 + n;
        v4u o; o.x = pk2(s[0 * 33], s[1 * 33]); o.y = pk2(s[2 * 33], s[3 * 33]); o.z = pk2(s[4 * 33], s[5 * 33]); o.w = pk2(s[6 * 33], s[7 * 33]);
        *(GAS v4u*)(WT + (size_t)(drow0 + n) * K + k0 + 8 * c) = o; }
    LDS_WAIT(); asm volatile("" ::: "memory");
}
struct Job { int in, ld, src0, ncols, K, dst0, il, nw; size_t wt; };

struct Args { const float* in[23]; float* out; unsigned char* ws; int ph_lo, ph_hi; };

__device__ __forceinline__ Job get_job(int j) {
    switch (j) {
    case 0:  return Job{2, FF, 0, FF, D, 0, 1, 1, WS_WGU1};
    case 1:  return Job{3, FF, 0, FF, D, 0, 2, 1, WS_WGU1};
    case 2:  return Job{4, D, 0, D, FF, 0, 0, -1, WS_WD1};
    case 3:  return Job{6, NPROJ, 0, 4096, D, 0, 0, 5, WS_WIN};
    case 4:  return Job{6, NPROJ, 4096, 4096, D, 4096, 1, 5, WS_WIN};
    case 5:  return Job{6, NPROJ, 8192, 4096, D, 4096, 2, 5, WS_WIN};
    case 6:  return Job{6, NPROJ, 12288, 8192, D, 12288, 0, 5, WS_WIN};
    case 7:  return Job{6, NPROJ, 20480, 10240, D, 20480, 0, 5, WS_WIN};
    case 8:  return Job{6, NPROJ, 30848, 4096, D, 30720, 0, 5, WS_WIN};
    case 9:  return Job{6, NPROJ, 34944, 4096, D, 34816, 0, 5, WS_WIN};
    case 10: return Job{6, NPROJ, 30720, 128, D, 38912, 0, 5, WS_WIN};
    case 11: return Job{9, D, 0, D, D, 0, 0, -1, WS_WSC};
    case 12: return Job{16, D, 0, D, DI, 0, 0, 15, WS_WSS};
    case 13: return Job{17, D, 0, D, D, 0, 0, -1, WS_WO};
    case 14: return Job{19, FF, 0, FF, D, 0, 1, 18, WS_WGU2};
    case 15: return Job{20, FF, 0, FF, D, 0, 2, 18, WS_WGU2};
    default: return Job{21, D, 0, D, FF, 0, 0, -1, WS_WD2};
    }
}
constexpr int NJOBS = 17;
__host__ __device__ constexpr long job_items(int ncols, int K) { return (long)(K / 64) * (ncols / 32); }

__global__ void __launch_bounds__(NWAVES * 64, 2) hyb_fwd(Args args) {
    extern __shared__ __attribute__((aligned(16))) unsigned char lds[];
    Frame F;
    F.lds = (LAS unsigned char*)lds;
    F.MISC = (volatile LAS unsigned*)(F.lds + MISC_OFF);
    F.tid = threadIdx.x; F.lane = F.tid & 63; F.wave = __builtin_amdgcn_readfirstlane(F.tid >> 6);
    F.G = gridDim.x; { const int bx = blockIdx.x; F.vcu = (F.G % 8 == 0) ? (bx % 8) * (F.G / 8) + bx / 8 : bx; }
    unsigned char* ws = args.ws;
    F.ctl = (gu32*)(ws + WS_CTL);
    for (int u = F.tid; u < (LDS_BYTES - LDSCTL_OFF) / 4; u += NWAVES * 64) ((LAS unsigned*)(F.lds + LDSCTL_OFF))[u] = 0u;
    __syncthreads();
    XcdBarrier bar; bar.bar = (unsigned*)(F.ctl + CW_BAR); bar.x = 0; bar.st = nullptr;
    if (N_LAUNCHES == 1) bar = xcd_barrier_post((unsigned*)(F.ctl + CW_BAR), F.MISC + 8);
#define GRID_BAR() do { if (N_LAUNCHES == 1) xcd_barrier(bar); } while (0)
    const int lo = args.ph_lo, hi = args.ph_hi;
#define IN(k) (lo <= (k) && (k) < hi)
#define BOTH(k) (IN(k) && IN((k) + 1))
    const float* x_in = args.in[0];
    float* xres = args.out;
    bf16* Hb = (bf16*)(ws + WS_H); bf16* ACT = (bf16*)(ws + WS_ACT);
    bf16* CBb = (bf16*)(ws + WS_CB); bf16* Ub = (bf16*)(ws + WS_U); bf16* Zb = (bf16*)(ws + WS_Z); bf16* XBCb = (bf16*)(ws + WS_XBC);
    bf16* GAb = (bf16*)(ws + WS_GA); bf16* GBb = (bf16*)(ws + WS_GB); float* DTb = (float*)(ws + WS_DT);
    bf16* AIN = (bf16*)(ws + WS_AIN); bf16* YG = (bf16*)(ws + WS_YG); float* Tb = (float*)(ws + WS_T); bf16* MIX = (bf16*)(ws + WS_MIX);
    unsigned long long* RSQ1 = (unsigned long long*)(ws + WS_RSQ); unsigned long long* RSQ2 = RSQ1 + M; unsigned long long* RSQ3 = RSQ2 + M; unsigned long long* RSQ4 = RSQ3 + M;
    unsigned long long* GSQ = RSQ4 + M;
    const int gw = F.vcu * NWAVES + F.wave, NGW = F.G * NWAVES;

    if (IN(0)) {
        LAS float* scr = (LAS float*)(F.lds + RING_OFF + F.wave * 16384);
        long base = 0;
        for (int j = 0; j < NJOBS; ++j) {
            const Job jb = get_job(j); const int nblk = jb.ncols / 32; const long nit = job_items(jb.ncols, jb.K);
            const float* W = args.in[jb.in]; const float* nw = jb.nw >= 0 ? args.in[jb.nw] : nullptr; bf16* WT = (bf16*)(ws + jb.wt);
            long first = (long)gw - (base % NGW); if (first < 0) first += NGW;
            for (long it = first; it < nit; it += NGW) {
                const int kb = (int)(it / nblk), nb = (int)(it % nblk), c = 32 * nb;
                const int drow = jb.il == 0 ? jb.dst0 + c : jb.dst0 + (c >> 7) * 256 + (c & 127) + (jb.il == 2 ? 128 : 0);
                p0_transpose_item(W, jb.ld, jb.src0 + c, jb.K, WT, drow, nw, scr, kb, F.lane);
            }
            base += nit;
        }
        {
            v4u* z = (v4u*)((bf16*)(ws + WS_WIN) + (size_t)39040 * D); const size_t n16 = (size_t)128 * D * 2 / 16;
            for (size_t i = (size_t)blockIdx.x * (NWAVES * 64) + F.tid; i < n16; i += (size_t)F.G * NWAVES * 64) z[i] = (v4u){0u, 0u, 0u, 0u};
        }
        for (int m = gw; m < M; m += NGW) {
            const GAS f32x4* xr = (const GAS f32x4*)(x_in + (size_t)m * D) + F.lane; GAS unsigned long long* o8 = (GAS unsigned long long*)(Hb + (size_t)m * D) + F.lane; float s = 0.f;
#pragma unroll
            for (int j = 0; j < 16; ++j) { const f32x4 v = xr[64 * j]; s += (v.x * v.x + v.y * v.y) + (v.z * v.z + v.w * v.w);
                o8[64 * j] = (unsigned long long)pg8::cvt_pk_bf16(v.x, v.y) | ((unsigned long long)pg8::cvt_pk_bf16(v.z, v.w) << 32); }
            s = wave_sum(s);
            if (F.lane == 0) RSQ1[m] = pg8::rsq_fix(s);
        }
        if (BOTH(0)) GRID_BAR();
    }
    if (IN(1)) {
        pg8::Gemm g{Hb, (const bf16*)(ws + WS_WGU1), M, 2 * FF, D}; pg8::StaticOrder S; S.init(M, 2 * FF, F.G, (int)blockIdx.x);
        pg8::EpiGateUp E{ACT, FF, RSQ1, 1.0f / D};
        pg8::gemm_phase<pg8::EpiGateUp, pg8::StaticOrder, true, true>(F.lds + RING_OFF, g, S, E);
        if (BOTH(1)) GRID_BAR();
    }
    if (IN(2)) {
        pg8::Gemm g{ACT, (const bf16*)(ws + WS_WD1), M, D, FF}; pg8::StaticOrder S; S.init(M, D, F.G, (int)blockIdx.x);
        pg8::EpiResid<true> E{x_in, xres, Hb, RSQ2, 0.5f, D};
        pg8::gemm_phase<pg8::EpiResid<true>, pg8::StaticOrder, true, true>(F.lds + RING_OFF, g, S, E);
        if (BOTH(2)) GRID_BAR();
    }
    if (IN(3)) {
        pg8::Gemm g{Hb, (const bf16*)(ws + WS_WIN), M, NPROJ_PAD, D}; pg8::StaticOrder S; S.init(M, NPROJ_PAD, F.G, (int)blockIdx.x);
        pg8::EpiProj E{CBb, Ub, Zb, XBCb, GAb, GBb, DTb, args.in[7], args.in[12], RSQ2, 1.0f / D};
        pg8::gemm_phase<pg8::EpiProj, pg8::StaticOrder, true, true>(F.lds + RING_OFF, g, S, E);
        if (BOTH(3)) GRID_BAR();
    }
    if (IN(4)) {
        {
            const float* cw = args.in[8]; const int c8 = F.tid * 8;
            float w0[8], w1[8], w2[8];
#pragma unroll
            for (int i = 0; i < 8; ++i) { w0[i] = cw[c8 + i]; w1[i] = cw[4096 + c8 + i]; w2[i] = cw[8192 + c8 + i]; }
            for (int strip = blockIdx.x; strip < M / 32; strip += F.G) {
                const int r0 = strip * 32; v4u um2 = (v4u){0u, 0u, 0u, 0u}, um1 = um2;
                if ((r0 % SEQ) != 0) { um2 = *(const v4u*)(Ub + (size_t)(r0 - 2) * 4096 + c8); um1 = *(const v4u*)(Ub + (size_t)(r0 - 1) * 4096 + c8); }
#pragma unroll 4
                for (int r = r0; r < r0 + 32; ++r) {
                    const v4u u0 = *(const v4u*)(Ub + (size_t)r * 4096 + c8), cb = *(const v4u*)(CBb + (size_t)r * 4096 + c8);
                    const unsigned a[4] = {um2.x, um2.y, um2.z, um2.w}, b[4] = {um1.x, um1.y, um1.z, um1.w}, c[4] = {u0.x, u0.y, u0.z, u0.w}, d[4] = {cb.x, cb.y, cb.z, cb.w};
                    unsigned o[4];
#pragma unroll
                    for (int q = 0; q < 4; ++q) {
                        const float lo_ = bf_lo(d[q]) * (w0[2 * q] * bf_lo(a[q]) + w1[2 * q] * bf_lo(b[q]) + w2[2 * q] * bf_lo(c[q]));
                        const float hi_ = bf_hi(d[q]) * (w0[2 * q + 1] * bf_hi(a[q]) + w1[2 * q + 1] * bf_hi(b[q]) + w2[2 * q + 1] * bf_hi(c[q]));
                        o[q] = pg8::cvt_pk_bf16(lo_, hi_); }
                    *(v4u*)(AIN + (size_t)r * 4096 + c8) = (v4u){o[0], o[1], o[2], o[3]};
                    um2 = um1; um1 = u0;
                }
            }
        }
        {
            LAS float* Bs = (LAS float*)(F.lds);
            LAS float* Cs = (LAS float*)(F.lds + 32768);
            LAS float* Xs = (LAS float*)(F.lds + 65536);
            LAS float* Ys = (LAS float*)(F.lds + 98304);
            LAS float* DD = (LAS float*)(F.lds + SSD_DD_OFF);
            const float* convw = args.in[10]; const float* convb = args.in[11];
            for (int unit = blockIdx.x; unit < BATCH * (NH / 2); unit += F.G) {
                const int b = unit / (NH / 2), h0 = 2 * (unit % (NH / 2)), g = h0 >> 4;
                const int pl = F.lane >> 3, ns = F.lane & 7, p = F.wave * 8 + pl;
                const float A0 = -__expf(args.in[13][h0]), A1 = -__expf(args.in[13][h0 + 1]), D0 = args.in[14][h0], D1 = args.in[14][h0 + 1];
                float S0[16], S1[16];
#pragma unroll
                for (int k = 0; k < 16; ++k) { S0[k] = 0.f; S1[k] = 0.f; }
                const int cg = F.tid % 48, ts = F.tid / 48;
                const int scol = cg < 16 ? DI + g * 128 + cg * 8 : cg < 32 ? DI + 1024 + g * 128 + (cg - 16) * 8 : h0 * 64 + (cg - 32) * 8;
                float cw[4][8], cbias[8];
                if (F.tid < 384) {
#pragma unroll
                    for (int k = 0; k < 4; ++k)
#pragma unroll
                        for (int i = 0; i < 8; ++i) cw[k][i] = convw[k * CONVDIM + scol + i];
#pragma unroll
                    for (int i = 0; i < 8; ++i) cbias[i] = convb[scol + i];
                }
                for (int blk = 0; blk < SEQ / 64; ++blk) {
                    const int t0 = blk * 64; const size_t row0 = (size_t)b * SEQ + t0;
                    __syncthreads();
                    if (F.tid < 384) {
                        v4u raw[11];
#pragma unroll
                        for (int j = 0; j < 11; ++j) { const int tl = t0 + ts * 8 - 3 + j;
                            raw[j] = tl >= 0 ? *(const v4u*)(XBCb + ((size_t)b * SEQ + tl) * CONVDIM + scol) : (v4u){0u, 0u, 0u, 0u}; }
                        LAS float* dst = cg < 16 ? Bs + cg * 8 : cg < 32 ? Cs + (cg - 16) * 8 : Xs + (cg - 32) * 8;
#pragma unroll
                        for (int r = 0; r < 8; ++r) { float o[8];
#pragma unroll
                            for (int i = 0; i < 8; ++i) o[i] = cbias[i];
#pragma unroll
                            for (int k = 0; k < 4; ++k) { const v4u w = raw[r + k]; const unsigned ww[4] = {w.x, w.y, w.z, w.w};
#pragma unroll
                                for (int q = 0; q < 4; ++q) { o[2 * q] += cw[k][2 * q] * bf_lo(ww[q]); o[2 * q + 1] += cw[k][2 * q + 1] * bf_hi(ww[q]); } }
#pragma unroll
                            for (int i = 0; i < 8; ++i) o[i] = pg8::fast_silu(o[i]);
                            LAS f32x4* d4 = (LAS f32x4*)(dst + (ts * 8 + r) * 128);
                            d4[0] = (f32x4){o[0], o[1], o[2], o[3]}; d4[1] = (f32x4){o[4], o[5], o[6], o[7]}; }
                    } else {
                        const int idx = F.tid - 384, hh = idx >> 6, t = idx & 63;
                        const float dtv = DTb[(row0 + t) * 128 + h0 + hh]; const float dec = __expf(dtv * (hh ? A1 : A0));
                        DD[t * 4 + 2 * hh] = dtv; DD[t * 4 + 2 * hh + 1] = dec;
                    }
                    __syncthreads();
#pragma unroll 2
                    for (int t = 0; t < 64; ++t) {
                        const f32x4 dd = *(const LAS f32x4*)(DD + t * 4);
                        const float x0 = Xs[t * 128 + p], x1 = Xs[t * 128 + 64 + p];
                        const float xd0 = x0 * dd.x, xd1 = x1 * dd.z;
                        float y0 = 0.f, y1 = 0.f;
#pragma unroll
                        for (int j = 0; j < 4; ++j) {
                            const f32x4 bv = *(const LAS f32x4*)(Bs + t * 128 + 32 * j + 4 * ns), cv = *(const LAS f32x4*)(Cs + t * 128 + 32 * j + 4 * ns);
#pragma unroll
                            for (int i = 0; i < 4; ++i) {
                                S0[4 * j + i] = S0[4 * j + i] * dd.y + xd0 * bv[i]; y0 += cv[i] * S0[4 * j + i];
                                S1[4 * j + i] = S1[4 * j + i] * dd.w + xd1 * bv[i]; y1 += cv[i] * S1[4 * j + i]; }
                        }
                        y0 += __shfl_xor(y0, 1); y1 += __shfl_xor(y1, 1); y0 += __shfl_xor(y0, 2); y1 += __shfl_xor(y1, 2); y0 += __shfl_xor(y0, 4); y1 += __shfl_xor(y1, 4);
                        if (ns == 0) { Ys[t * 128 + p] = y0 + D0 * x0; Ys[t * 128 + 64 + p] = y1 + D1 * x1; }
                    }
                    __syncthreads();
                    {
                        const int row = F.tid >> 3, seg = F.tid & 7; const size_t grow = row0 + row;
                        const v4u z0 = *(const v4u*)(Zb + grow * DI + h0 * 64 + seg * 16), z1 = *(const v4u*)(Zb + grow * DI + h0 * 64 + seg * 16 + 8);
                        const LAS f32x4* yp = (const LAS f32x4*)(Ys + row * 128 + seg * 16);
                        f32x4 za, zb, zc, zd; pg8::unpack8(z0, za, zb); pg8::unpack8(z1, zc, zd);
                        const f32x4 v0 = yp[0] * za, v1 = yp[1] * zb, v2 = yp[2] * zc, v3 = yp[3] * zd;
                        float ss = 0.f;
#pragma unroll
                        for (int i = 0; i < 4; ++i) ss += (v0[i] * v0[i] + v1[i] * v1[i]) + (v2[i] * v2[i] + v3[i] * v3[i]);
                        *(v4u*)(YG + grow * DI + h0 * 64 + seg * 16) = pg8::pack8(v0, v1); *(v4u*)(YG + grow * DI + h0 * 64 + seg * 16 + 8) = pg8::pack8(v2, v3);
                        ss += __shfl_xor(ss, 1); ss += __shfl_xor(ss, 2); ss += __shfl_xor(ss, 4);
                        if (seg == 0) atomicAdd(GSQ + grow * 8 + g, pg8::rsq_fix(ss));
                    }
                }
            }
        }
        if (BOTH(4)) GRID_BAR();
    }
    if (IN(5)) {
        for (int m = gw; m < M; m += NGW) {
            GAS v4u* yr = (GAS v4u*)(YG + (size_t)m * DI) + F.lane;
#pragma unroll 4
            for (int j = 0; j < 16; ++j) { const float rs = pg8::rstd_of(GSQ, m * 8 + (j >> 1), 1.0f / 1024.0f, pg8::RMS_EPS_F);
                const v4u w = yr[64 * j]; f32x4 a, b2; pg8::unpack8(w, a, b2); yr[64 * j] = pg8::pack8(a * rs, b2 * rs); }
        }
        if (BOTH(5)) GRID_BAR();
    }
    if (IN(6)) {
        pg8::Gemm g{AIN, (const bf16*)(ws + WS_WSC), M, D, D}; pg8::StaticOrder S; S.init(M, D, F.G, (int)blockIdx.x);
        pg8::EpiScA E{GAb, Tb};
        pg8::gemm_phase<pg8::EpiScA, pg8::StaticOrder, true, true>(F.lds + RING_OFF, g, S, E);
        if (BOTH(6)) GRID_BAR();
    }
    if (IN(7)) {
        pg8::Gemm g{YG, (const bf16*)(ws + WS_WSS), M, D, DI}; pg8::StaticOrder S; S.init(M, D, F.G, (int)blockIdx.x);
        pg8::EpiSsB E{GBb, Tb, MIX};
        pg8::gemm_phase<pg8::EpiSsB, pg8::StaticOrder, true, true>(F.lds + RING_OFF, g, S, E);
        if (BOTH(7)) GRID_BAR();
    }
    if (IN(8)) {
        pg8::Gemm g{MIX, (const bf16*)(ws + WS_WO), M, D, D}; pg8::StaticOrder S; S.init(M, D, F.G, (int)blockIdx.x);
        pg8::EpiResid<true> E{xres, xres, Hb, RSQ3, 1.0f, D};
        pg8::gemm_phase<pg8::EpiResid<true>, pg8::StaticOrder, true, true>(F.lds + RING_OFF, g, S, E);
        if (BOTH(8)) GRID_BAR();
    }
    if (IN(9)) {
        pg8::Gemm g{Hb, (const bf16*)(ws + WS_WGU2), M, 2 * FF, D}; pg8::StaticOrder S; S.init(M, 2 * FF, F.G, (int)blockIdx.x);
        pg8::EpiGateUp E{ACT, FF, RSQ3, 1.0f / D};
        pg8::gemm_phase<pg8::EpiGateUp, pg8::StaticOrder, true, true>(F.lds + RING_OFF, g, S, E);
        if (BOTH(9)) GRID_BAR();
    }
    if (IN(10)) {
        pg8::Gemm g{ACT, (const bf16*)(ws + WS_WD2), M, D, FF}; pg8::StaticOrder S; S.init(M, D, F.G, (int)blockIdx.x);
        pg8::EpiResid<false> E{xres, xres, nullptr, RSQ4, 0.5f, D};
        pg8::gemm_phase<pg8::EpiResid<false>, pg8::StaticOrder, true, true>(F.lds + RING_OFF, g, S, E);
        if (BOTH(10)) GRID_BAR();
    }
    if (IN(11)) {
        const float* fw = args.in[22];
        for (int m = gw; m < M; m += NGW) {
            const float rs = pg8::rstd_of(RSQ4, m, 1.0f / D, pg8::RMS_EPS_F);
            GAS f32x4* xr = (GAS f32x4*)(xres + (size_t)m * D) + F.lane; const f32x4* wr4 = (const f32x4*)fw + F.lane;
#pragma unroll 4
            for (int j = 0; j < 16; ++j) { const f32x4 v = xr[64 * j]; xr[64 * j] = v * rs * wr4[64 * j]; }
        }
    }
#undef IN
#undef BOTH
#undef GRID_BAR
}

extern "C" void kernel_launch(void* const* d_in, const int* in_sizes, int n_in, void* d_out, int out_size, void* d_ws, size_t ws_size, hipStream_t stream) {
    static int grid = 0;
    if (grid == 0) {
        if (n_in != 23 || in_sizes[0] != M * D || out_size != M * D || ws_size < WS_END) { fprintf(stderr, "kernel_launch: unexpected shapes / workspace (n_in %d, in0 %d, out %d, ws %zu, need %zu); nothing launched\n", n_in, n_in > 0 ? in_sizes[0] : -1, out_size, ws_size, (size_t)WS_END); grid = -1; return; }
        int dev = 0, cus = 0, per_cu = 0;
        if (hipGetDevice(&dev) != hipSuccess || hipDeviceGetAttribute(&cus, hipDeviceAttributeMultiprocessorCount, dev) != hipSuccess) { grid = -1; return; }
        if (hipFuncSetAttribute((const void*)hyb_fwd, hipFuncAttributeMaxDynamicSharedMemorySize, LDS_BYTES) != hipSuccess) { fprintf(stderr, "kernel_launch: hipFuncSetAttribute failed\n"); grid = -1; return; }
        if (hipOccupancyMaxActiveBlocksPerMultiprocessor(&per_cu, (const void*)hyb_fwd, NWAVES * 64, LDS_BYTES) != hipSuccess || per_cu < 1)
            fprintf(stderr, "kernel_launch: note: occupancy query reports %d workgroups per CU\n", per_cu);
        (void)hipGetLastError();
        grid = cus;
    }
    if (grid < 0) return;
    if (hipMemsetAsync((char*)d_ws + WS_CTL, 0, CTL_ZERO_BYTES, stream) != hipSuccess) { fprintf(stderr, "kernel_launch: memset failed\n"); return; }
    Args a{};
    for (int i = 0; i < 23; ++i) a.in[i] = (const float*)d_in[i];
    a.out = (float*)d_out; a.ws = (unsigned char*)d_ws;
    for (int li = 0; li < N_LAUNCHES; ++li) {
        a.ph_lo = (N_LAUNCHES == 1) ? 0 : li; a.ph_hi = (N_LAUNCHES == 1) ? NPHASE : li + 1;
        hipLaunchKernelGGL(hyb_fwd, dim3(grid), dim3(NWAVES * 64), LDS_BYTES, stream, a);
        const hipError_t le = hipPeekAtLastError();
        if (le != hipSuccess) { fprintf(stderr, "kernel_launch: launch %d failed: %s\n", li, hipGetErrorName(le)); break; }
    }
}
```

```cpp
#include <hip/hip_runtime.h>
#include <hip/hip_cooperative_groups.h>
#include <cstdio>
#include <cstdint>
namespace pg8 {
#define PG8_LAS __attribute__((address_space(3)))
typedef unsigned short bf16_t;
typedef short bf16x8 __attribute__((ext_vector_type(8)));
typedef float f32x4 __attribute__((ext_vector_type(4)));
typedef unsigned u32x4 __attribute__((ext_vector_type(4)));
constexpr int BM = 256, BK = 64, HALF = 128, HTB = HALF * BK * 2  , STAGE_BYTES = 8 * HTB, NXCD = 8, WGM = 8;

__host__ __device__ __forceinline__ int lds_byte(int r, int c) { const int st = (r >> 4) * 2 + (c >> 5), rr = r & 15, cc = c & 31, ob = rr * 64 + cc * 2; return st * 1024 + (ob ^ (((ob >> 9) & 1) << 5)); }
__host__ __device__ __forceinline__ void stage_rc(int b, int& R, int& C) { const int st = b / 1024, sb = b % 1024, swz = sb ^ (((sb >> 9) & 1) << 5); R = (st >> 1) * 16 + swz / 64; C = (st & 1) * 32 + (swz % 64) / 2; }
__host__ __device__ __forceinline__ int perm32(int rho) { const int n = rho >> 4, i = rho & 15; return 8 * (i >> 2) + 4 * n + (i & 3); }

struct Unit { int pm, pn; };
struct Gemm { const bf16_t* A; const bf16_t* Bt; int M, N, K, ld; };

struct StaticOrder {
    int nM, nN, nwg, G, c;
    __host__ __device__ void init(int M, int N, int G_, int c_) { nM = M / BM; nN = N / BM; nwg = nM * nN; G = G_; c = c_; }
    __host__ __device__ bool next(int i, Unit& u) const {
        const long L = (long)i * G + c; if (L >= nwg) return false;
        int wgid = (int)L; { const int q = nwg / NXCD, r = nwg % NXCD, xcd = wgid % NXCD, off = wgid / NXCD; wgid = (xcd < r ? xcd * (q + 1) : r * (q + 1) + (xcd - r) * q) + off; }
        const int nig = WGM * nN, gid = wgid / nig, fm = gid * WGM, gsz = (nM - fm) < WGM ? (nM - fm) : WGM;
        u.pm = fm + ((wgid % nig) % gsz); u.pn = (wgid % nig) / gsz; return true;
    }
    __device__ __forceinline__ void a_ready(const Unit&) const {}
    __device__ __forceinline__ void done(const Unit&) const {}
};

__device__ __forceinline__ unsigned cvt_pk_bf16(float lo, float hi) { unsigned r; asm volatile("v_cvt_pk_bf16_f32 %0, %1, %2" : "=v"(r) : "v"(lo), "v"(hi)); return r; }
typedef float f32x2 __attribute__((ext_vector_type(2)));

constexpr float RSQ_SCALE = 16777216.0f, RSQ_INV = 1.0f / 16777216.0f;
__device__ __forceinline__ unsigned long long rsq_fix(float s) { return (unsigned long long)(s * RSQ_SCALE + 0.5f); }
__device__ __forceinline__ float rstd_of(const unsigned long long* rsq, int row, float inv_n, float eps) {
    const unsigned long long v = rsq[row]; return __builtin_amdgcn_rsqf((float)v * (RSQ_INV * inv_n) + eps); }
__device__ __forceinline__ float fast_sigmoid(float v) { return __builtin_amdgcn_rcpf(1.0f + __builtin_amdgcn_exp2f(v * -1.44269504089f)); }
__device__ __forceinline__ float fast_silu(float v) { return v * fast_sigmoid(v); }
__device__ __forceinline__ u32x4 pack8(const f32x4 a, const f32x4 b) { u32x4 w; w.x = cvt_pk_bf16(a[0], a[1]); w.y = cvt_pk_bf16(a[2], a[3]); w.z = cvt_pk_bf16(b[0], b[1]); w.w = cvt_pk_bf16(b[2], b[3]); return w; }
__device__ __forceinline__ void unpack8(const u32x4 w, f32x4& a, f32x4& b) {
    a[0] = __uint_as_float(w.x << 16); a[1] = __uint_as_float(w.x & 0xffff0000u); a[2] = __uint_as_float(w.y << 16); a[3] = __uint_as_float(w.y & 0xffff0000u);
    b[0] = __uint_as_float(w.z << 16); b[1] = __uint_as_float(w.z & 0xffff0000u); b[2] = __uint_as_float(w.w << 16); b[3] = __uint_as_float(w.w & 0xffff0000u); }
constexpr float RMS_EPS_F = 1e-5f;

struct EpiGateUp {
    static constexpr bool PERM = true, AFTER_DRAIN = false;
    bf16_t* O; int ldc; const unsigned long long* rsq; float inv_n;
    __device__ __forceinline__ void operator()(const f32x4 (&acc)[2][2][4][2], const Unit& u, int wr, int wc, int fr, int fq) const {
        const int row0 = u.pm * BM + wr * 64 + fr, col0 = u.pn * HALF + wc * 32 + 8 * fq;
#pragma unroll
        for (int ai = 0; ai < 2; ++ai)
#pragma unroll
            for (int m = 0; m < 4; ++m) { const int row = row0 + ai * HALF + m * 16; const float rs = rstd_of(rsq, row, inv_n, RMS_EPS_F);
                f32x4 o[2];
#pragma unroll
                for (int n = 0; n < 2; ++n)
#pragma unroll
                    for (int j = 0; j < 4; ++j) o[n][j] = fast_silu(acc[ai][0][m][n][j] * rs) * (acc[ai][1][m][n][j] * rs);
                *(u32x4*)(O + (size_t)row * ldc + col0) = pack8(o[0], o[1]); }
    }
};
template <bool WITH_HB> struct EpiResid {
    static constexpr bool PERM = true, AFTER_DRAIN = false;
    const float* base; float* out; bf16_t* hb; unsigned long long* rsq_out; float scale; int ldc;
    __device__ __forceinline__ void operator()(const f32x4 (&acc)[2][2][4][2], const Unit& u, int wr, int wc, int fr, int fq) const {
        const int row0 = u.pm * BM + wr * 64 + fr, col0 = u.pn * BM + wc * 32 + 8 * fq;
#pragma unroll
        for (int ai = 0; ai < 2; ++ai)
#pragma unroll
            for (int m = 0; m < 4; ++m) { const int row = row0 + ai * HALF + m * 16; const size_t off = (size_t)row * ldc + col0; float ss = 0.f;
#pragma unroll
                for (int bj = 0; bj < 2; ++bj) {
                    const f32x4 b0 = *(const f32x4*)(base + off + bj * HALF), b1 = *(const f32x4*)(base + off + bj * HALF + 4);
                    const f32x4 v0 = b0 + acc[ai][bj][m][0] * scale, v1 = b1 + acc[ai][bj][m][1] * scale;
                    *(f32x4*)(out + off + bj * HALF) = v0; *(f32x4*)(out + off + bj * HALF + 4) = v1;
                    if (WITH_HB) *(u32x4*)(hb + off + bj * HALF) = pack8(v0, v1);
                    ss += (v0[0] * v0[0] + v0[1] * v0[1]) + (v0[2] * v0[2] + v0[3] * v0[3]) + (v1[0] * v1[0] + v1[1] * v1[1]) + (v1[2] * v1[2] + v1[3] * v1[3]); }
                ss += __shfl_xor(ss, 16); ss += __shfl_xor(ss, 32);
                if (fq == 0) atomicAdd(rsq_out + row, rsq_fix(ss));
                if (m == 3) asm volatile("" ::: "memory"); }
    }
};
struct EpiProj {
    static constexpr bool PERM = true, AFTER_DRAIN = false;
    bf16_t *CB, *U, *Z, *XBC, *GA, *GB; const float* gbias; const unsigned long long* rsq; float inv_n;
    template <int ACT  >
    __device__ __forceinline__ void plain(const f32x4 (&acc)[2][2][4][2], bf16_t* O, int ldc, int colt, const float* bias, int row0, int wc, int fq) const {
        const int col0 = colt + wc * 32 + 8 * fq;
        f32x4 bv[2][2];
#pragma unroll
        for (int bj = 0; bj < 2; ++bj)
#pragma unroll
            for (int n = 0; n < 2; ++n) bv[bj][n] = (ACT == 2) ? *(const f32x4*)(bias + col0 + bj * HALF + 4 * n) : (f32x4){0.f, 0.f, 0.f, 0.f};
#pragma unroll
        for (int ai = 0; ai < 2; ++ai)
#pragma unroll
            for (int m = 0; m < 4; ++m) { const int row = row0 + ai * HALF + m * 16; const float rs = rstd_of(rsq, row, inv_n, RMS_EPS_F);
#pragma unroll
                for (int bj = 0; bj < 2; ++bj) { f32x4 o[2];
#pragma unroll
                    for (int n = 0; n < 2; ++n)
#pragma unroll
                        for (int j = 0; j < 4; ++j) { const float v = acc[ai][bj][m][n][j] * rs; o[n][j] = (ACT == 0) ? v : (ACT == 1) ? fast_silu(v) : fast_sigmoid(v + bv[bj][n][j]); }
                    *(u32x4*)(O + (size_t)row * ldc + col0 + bj * HALF) = pack8(o[0], o[1]); } }
    }
    __device__ __forceinline__ void operator()(const f32x4 (&acc)[2][2][4][2], const Unit& u, int wr, int wc, int fr, int fq) const {
        const int row0 = u.pm * BM + wr * 64 + fr, pn = u.pn;
        if (pn < 16) plain<0>(acc, CB, 4096, pn * BM, nullptr, row0, wc, fq);
        else if (pn < 48) {
            const int col0 = (pn - 16) * HALF + wc * 32 + 8 * fq;
#pragma unroll
            for (int ai = 0; ai < 2; ++ai)
#pragma unroll
                for (int m = 0; m < 4; ++m) { const int row = row0 + ai * HALF + m * 16; const float rs = rstd_of(rsq, row, inv_n, RMS_EPS_F); const float rs2 = rs * rs;
                    f32x4 o[2];
#pragma unroll
                    for (int n = 0; n < 2; ++n) o[n] = (acc[ai][0][m][n] * acc[ai][1][m][n]) * rs2;
                    *(u32x4*)(U + (size_t)row * 4096 + col0) = pack8(o[0], o[1]); }
        }
        else if (pn < 80) plain<1>(acc, Z, 8192, (pn - 48) * BM, nullptr, row0, wc, fq);
        else if (pn < 120) plain<0>(acc, XBC, 10240, (pn - 80) * BM, nullptr, row0, wc, fq);
        else if (pn < 136) plain<2>(acc, GA, 4096, (pn - 120) * BM, gbias, row0, wc, fq);
        else plain<2>(acc, GB, 4096, (pn - 136) * BM, gbias + 4096, row0, wc, fq);
    }
};
struct EpiDtPart {
    static constexpr bool PERM = true, AFTER_DRAIN = false;
    float* P;
    __device__ __forceinline__ void operator()(const f32x4 (&acc)[2][2][4][2], const Unit& u, int wr, int wc, int fr, int fq) const {
        const int row0 = u.pm * BM + wr * 64 + fr, col0 = wc * 32 + 8 * fq;
#pragma unroll
        for (int ai = 0; ai < 2; ++ai)
#pragma unroll
            for (int m = 0; m < 4; ++m) { float* p = P + (size_t)(row0 + ai * HALF + m * 16) * 128 + col0; *(f32x4*)p = acc[ai][0][m][0]; *(f32x4*)(p + 4) = acc[ai][0][m][1]; }
    }
};
struct ProbeOrder : StaticOrder {
    __device__ __forceinline__ bool next(int i, Unit& u) const { const bool r = StaticOrder::next(i, u); u.pm = 0; u.pn = 0; return r; }
};
struct OneUnit {
    int pm;
    __device__ __forceinline__ bool next(int i, Unit& u) const { if (i != 0) return false; u.pm = pm; u.pn = 0; return true; }
    __device__ __forceinline__ void a_ready(const Unit&) const {}
    __device__ __forceinline__ void done(const Unit&) const {}
};
struct EpiScA {
    static constexpr bool PERM = true, AFTER_DRAIN = false;
    const bf16_t* GA; float* T;
    __device__ __forceinline__ void operator()(const f32x4 (&acc)[2][2][4][2], const Unit& u, int wr, int wc, int fr, int fq) const {
        const int row0 = u.pm * BM + wr * 64 + fr, col0 = u.pn * BM + wc * 32 + 8 * fq;
#pragma unroll
        for (int ai = 0; ai < 2; ++ai)
#pragma unroll
            for (int m = 0; m < 4; ++m) { const size_t off = (size_t)(row0 + ai * HALF + m * 16) * 4096 + col0;
#pragma unroll
                for (int bj = 0; bj < 2; ++bj) { f32x4 g0, g1; unpack8(*(const u32x4*)(GA + off + bj * HALF), g0, g1);
                    *(f32x4*)(T + off + bj * HALF) = g0 * acc[ai][bj][m][0]; *(f32x4*)(T + off + bj * HALF + 4) = g1 * acc[ai][bj][m][1]; }
                if (m == 3) asm volatile("" ::: "memory"); }
    }
};
struct EpiSsB {
    static constexpr bool PERM = true, AFTER_DRAIN = false;
    const bf16_t* GB; const float* T; bf16_t* MIX;
    __device__ __forceinline__ void operator()(const f32x4 (&acc)[2][2][4][2], const Unit& u, int wr, int wc, int fr, int fq) const {
        const int row0 = u.pm * BM + wr * 64 + fr, col0 = u.pn * BM + wc * 32 + 8 * fq;
#pragma unroll
        for (int ai = 0; ai < 2; ++ai)
#pragma unroll
            for (int m = 0; m < 4; ++m) { const size_t off = (size_t)(row0 + ai * HALF + m * 16) * 4096 + col0;
#pragma unroll
                for (int bj = 0; bj < 2; ++bj) { f32x4 g0, g1; unpack8(*(const u32x4*)(GB + off + bj * HALF), g0, g1);
                    const f32x4 t0 = *(const f32x4*)(T + off + bj * HALF), t1 = *(const f32x4*)(T + off + bj * HALF + 4);
                    *(u32x4*)(MIX + off + bj * HALF) = pack8(t0 + g0 * acc[ai][bj][m][0], t1 + g1 * acc[ai][bj][m][1]); }
                if (m == 3) asm volatile("" ::: "memory"); }
    }
};


template <class Epi, class Sched, bool ALIGN_EPI = false, bool SP2 = false>
__device__ __forceinline__ void gemm_phase(PG8_LAS unsigned char* lds, const Gemm g, const Sched& S, const Epi& E) {
    const int tid = threadIdx.x, wid = __builtin_amdgcn_readfirstlane(tid >> 6), lane = tid & 63, wr = wid >> 2, wc = wid & 3, fr = lane & 15, fq = lane >> 4;
    const int K = g.ld, nt = g.K / BK;
    unsigned voffA[2], voffB[2];
#pragma unroll
    for (int i = 0; i < 2; ++i) { int R, C; stage_rc(tid * 16 + i * 8192, R, C); const int Rb = Epi::PERM ? ((R & ~31) + perm32(R & 31)) : R;
        voffA[i] = (unsigned)(R * K + C) * 2u; voffB[i] = (unsigned)(Rb * K + C) * 2u; }
    const size_t kstep = (size_t)(BK * 2);
    const size_t hstep = (size_t)HALF * K * 2;
    const size_t tstep = 2 * hstep;
    const unsigned ldsw = (unsigned)wid * 1024u;
    const int aoff = lds_byte(wr * 64 + fr, fq * 8), boff = lds_byte(wc * 32 + fr, fq * 8);
#define PG8_SA(b, h) (((b) * 2 + (h)) * HTB)
#define PG8_SB(b, h) ((4 + (b) * 2 + (h)) * HTB)
#define PG8_STAGE(bufoff, gbase, voff) do { _Pragma("unroll") for (int _i = 0; _i < 2; ++_i) \
        __builtin_amdgcn_global_load_lds((const unsigned*)((const char*)(gbase) + (voff)[_i]), (PG8_LAS unsigned*)(lds + (bufoff) + ldsw + _i * 8192), 16, 0, 0); } while (0)
#define PG8_LDA(dst, b, h) do { _Pragma("unroll") for (int m = 0; m < 4; ++m) _Pragma("unroll") for (int k = 0; k < 2; ++k) dst[m][k] = *(const PG8_LAS bf16x8*)(lds + PG8_SA(b, h) + aoff + m * 2048 + k * 1024); } while (0)
#define PG8_LDB(dst, b, h) do { _Pragma("unroll") for (int n = 0; n < 2; ++n) _Pragma("unroll") for (int k = 0; k < 2; ++k) dst[n][k] = *(const PG8_LAS bf16x8*)(lds + PG8_SB(b, h) + boff + n * 2048 + k * 1024); } while (0)
#define PG8_MMA(ai, bj, At, Bt) do { __builtin_amdgcn_s_setprio(1); _Pragma("unroll") for (int m = 0; m < 4; ++m) _Pragma("unroll") for (int n = 0; n < 2; ++n) _Pragma("unroll") for (int k = 0; k < 2; ++k) \
        acc[ai][bj][m][n] = __builtin_amdgcn_mfma_f32_16x16x32_bf16(Bt[n][k], At[m][k], acc[ai][bj][m][n], 0, 0, 0); __builtin_amdgcn_s_setprio(0); } while (0)
#define PG8_WAIT_V(n) asm volatile("s_waitcnt vmcnt(" #n ")" ::: "memory")
#define PG8_WAIT_L(n) asm volatile("s_waitcnt lgkmcnt(" #n ")" ::: "memory")
#define PG8_BAR __builtin_amdgcn_s_barrier()
#define PG8_SCHED __builtin_amdgcn_sched_barrier(0)
    Unit cur, nxt; int ui = 0;
    if (!S.next(0, cur)) return;
    f32x4 acc[2][2][4][2];
#pragma unroll
    for (int a = 0; a < 2; ++a)
#pragma unroll
        for (int b = 0; b < 2; ++b)
#pragma unroll
            for (int m = 0; m < 4; ++m)
#pragma unroll
                for (int n = 0; n < 2; ++n) acc[a][b][m][n] = (f32x4){0.f, 0.f, 0.f, 0.f};
    bf16x8 At[4][2], B0[2][2], B1[2][2];
    const char* cA = (const char*)g.A + (size_t)cur.pm * tstep; const char* cB = (const char*)g.Bt + (size_t)cur.pn * tstep;
    S.a_ready(cur);
    if constexpr (SP2) {
        PG8_STAGE(PG8_SB(0, 0), cB, voffB); PG8_STAGE(PG8_SB(0, 1), cB + hstep, voffB); PG8_STAGE(PG8_SA(0, 0), cA, voffA); PG8_STAGE(PG8_SA(0, 1), cA + hstep, voffA);
        if (wr == 1) PG8_BAR;
        PG8_WAIT_V(2); PG8_BAR;
        PG8_STAGE(PG8_SB(1, 0), cB + kstep, voffB); PG8_STAGE(PG8_SA(1, 0), cA + kstep, voffA); PG8_STAGE(PG8_SB(1, 1), cB + hstep + kstep, voffB);
        PG8_WAIT_V(6); PG8_BAR;
    } else {
        PG8_STAGE(PG8_SB(0, 0), cB, voffB); PG8_STAGE(PG8_SA(0, 0), cA, voffA); PG8_STAGE(PG8_SB(0, 1), cB + hstep, voffB); PG8_STAGE(PG8_SA(0, 1), cA + hstep, voffA);
        if (wr == 1) PG8_BAR;
        PG8_WAIT_V(4); PG8_BAR;
        PG8_STAGE(PG8_SB(1, 0), cB + kstep, voffB); PG8_STAGE(PG8_SA(1, 0), cA + kstep, voffA); PG8_STAGE(PG8_SB(1, 1), cB + hstep + kstep, voffB);
        PG8_WAIT_V(6); PG8_BAR;
    }
    for (;;) {
        const bool has_next = S.next(ui + 1, nxt);
        const char* nA = has_next ? (const char*)g.A + (size_t)nxt.pm * tstep : cA; const char* nB = has_next ? (const char*)g.Bt + (size_t)nxt.pn * tstep : cB;
        for (int t = 0; t < nt; t += 2) {
            const bool last = (t == nt - 2);
            const char* a1 = cA + (size_t)(t + 1) * kstep;
            const char* a2 = last ? nA : cA + (size_t)(t + 2) * kstep; const char* b2 = last ? nB : cB + (size_t)(t + 2) * kstep;
            const char* a3 = a2 + kstep; const char* b3 = b2 + kstep;
            if (last && has_next) S.a_ready(nxt);
            if constexpr (SP2) {
            PG8_LDB(B0, 0, 0); PG8_LDB(B1, 0, 1); PG8_SCHED; PG8_LDA(At, 0, 0); PG8_STAGE(PG8_SA(1, 1), a1 + hstep, voffA);
            PG8_WAIT_V(8); PG8_WAIT_L(0); PG8_BAR; PG8_MMA(0, 0, At, B0); PG8_MMA(0, 1, At, B1); PG8_BAR; PG8_SCHED;
            PG8_LDA(At, 0, 1); PG8_STAGE(PG8_SB(0, 0), b2, voffB); PG8_STAGE(PG8_SB(0, 1), b2 + hstep, voffB); PG8_STAGE(PG8_SA(0, 0), a2, voffA);
            PG8_WAIT_V(8); PG8_WAIT_L(0); PG8_BAR; PG8_MMA(1, 0, At, B0); PG8_MMA(1, 1, At, B1); PG8_BAR; PG8_SCHED;
            PG8_LDB(B0, 1, 0); PG8_LDB(B1, 1, 1); PG8_SCHED; PG8_LDA(At, 1, 0); PG8_STAGE(PG8_SA(0, 1), a2 + hstep, voffA);
            PG8_WAIT_V(8); PG8_WAIT_L(0); PG8_BAR; PG8_MMA(0, 0, At, B0); PG8_MMA(0, 1, At, B1); PG8_BAR; PG8_SCHED;
            PG8_LDA(At, 1, 1); PG8_STAGE(PG8_SB(1, 0), b3, voffB); PG8_STAGE(PG8_SB(1, 1), b3 + hstep, voffB); PG8_STAGE(PG8_SA(1, 0), a3, voffA);
            PG8_WAIT_V(8); PG8_WAIT_L(0); PG8_BAR; PG8_MMA(1, 0, At, B0); PG8_MMA(1, 1, At, B1); PG8_BAR; PG8_SCHED;
            } else {
            PG8_LDB(B0, 0, 0); PG8_SCHED; PG8_LDA(At, 0, 0); PG8_STAGE(PG8_SA(1, 1), a1 + hstep, voffA);
            PG8_WAIT_L(8); PG8_BAR; PG8_WAIT_L(0); PG8_MMA(0, 0, At, B0); PG8_BAR; PG8_SCHED;
            PG8_LDB(B1, 0, 1); PG8_STAGE(PG8_SB(0, 0), b2, voffB);
            PG8_BAR; PG8_WAIT_L(0); PG8_MMA(0, 1, At, B1); PG8_BAR;
            PG8_LDA(At, 0, 1); PG8_STAGE(PG8_SA(0, 0), a2, voffA);
            PG8_BAR; PG8_WAIT_L(0); PG8_MMA(1, 0, At, B0); PG8_BAR; PG8_SCHED;
            PG8_STAGE(PG8_SB(0, 1), b2 + hstep, voffB);
            PG8_WAIT_V(6); PG8_BAR; PG8_MMA(1, 1, At, B1); PG8_BAR;
            PG8_LDB(B0, 1, 0); PG8_SCHED; PG8_LDA(At, 1, 0); PG8_STAGE(PG8_SA(0, 1), a2 + hstep, voffA);
            PG8_WAIT_L(8); PG8_BAR; PG8_WAIT_L(0); PG8_MMA(0, 0, At, B0); PG8_BAR; PG8_SCHED;
            PG8_LDB(B1, 1, 1); PG8_STAGE(PG8_SB(1, 0), b3, voffB);
            PG8_BAR; PG8_WAIT_L(0); PG8_MMA(0, 1, At, B1); PG8_BAR;
            PG8_LDA(At, 1, 1); PG8_STAGE(PG8_SA(1, 0), a3, voffA);
            PG8_BAR; PG8_WAIT_L(0); PG8_MMA(1, 0, At, B0); PG8_BAR; PG8_SCHED;
            PG8_STAGE(PG8_SB(1, 1), b3 + hstep, voffB);
            PG8_WAIT_V(6); PG8_BAR; PG8_MMA(1, 1, At, B1); PG8_BAR;
            }
        }
        if constexpr (ALIGN_EPI) { if (wr == 0) PG8_BAR; }
        if constexpr (!Epi::AFTER_DRAIN) { E(acc, cur, wr, wc, fr, fq); S.done(cur); }
        if (!has_next) break;
#pragma unroll
        for (int a = 0; a < 2; ++a)
#pragma unroll
            for (int b = 0; b < 2; ++b)
#pragma unroll
                for (int m = 0; m < 4; ++m)
#pragma unroll
                    for (int n = 0; n < 2; ++n) acc[a][b][m][n] = (f32x4){0.f, 0.f, 0.f, 0.f};
        cur = nxt; cA = nA; cB = nB; ++ui;
        if constexpr (ALIGN_EPI) { if (wr == 1) PG8_BAR; }
    }
    PG8_WAIT_V(0);
    if constexpr (!ALIGN_EPI) { if (wr == 0) PG8_BAR; }
    PG8_BAR;
    if constexpr (Epi::AFTER_DRAIN) { E.fused(acc, cur, wr, wc, fr, fq, lds, wid, lane); S.done(cur); }
#undef PG8_SA
#undef PG8_SB
#undef PG8_STAGE
#undef PG8_LDA
#undef PG8_LDB
#undef PG8_MMA
#undef PG8_WAIT_V
#undef PG8_WAIT_L
#undef PG8_BAR
#undef PG8_SCHED
}
}

constexpr int NWAVES = 8;
#ifndef MK_N_LAUNCHES
#define MK_N_LAUNCHES 1
#endif
#ifndef USE_CG_SYNC
#define USE_CG_SYNC 1
#endif
#ifndef PROBE_DUP
#define PROBE_DUP -1
#endif
#ifndef SSD_MFMA
#define SSD_MFMA 1
#endif
#ifndef XB_EVERY_WG_RELEASE
#define XB_EVERY_WG_RELEASE 1
#endif
#ifndef PG8_SP2
#define PG8_SP2 true
#endif
#ifndef PG8_ALIGN
#define PG8_ALIGN true
#endif
#ifndef PROBE_SYNCS
#define PROBE_SYNCS 0
#endif
#ifndef XB_LOGICAL_GROUPS
#define XB_LOGICAL_GROUPS 1
#endif
constexpr int NPHASE = 12;
constexpr int N_LAUNCHES = MK_N_LAUNCHES;
static_assert(N_LAUNCHES == 1 || N_LAUNCHES == NPHASE, "MK_N_LAUNCHES is 1 or NPHASE");
constexpr int BATCH = 4, SEQ = 2048, D = 4096, FF = 11008, DI = 8192, NH = 128, CONVDIM = 10240;
constexpr int M = BATCH * SEQ;
constexpr int NPROJ = 39040, NPROJ_MAIN = 38912, NPROJ_PAD = 39168;
constexpr int DT_KS = 8;

constexpr size_t MiB = 1u << 20;
constexpr size_t WS_CTL = 0, CTL_ZERO_BYTES = 2 * MiB;
constexpr size_t WS_RSQ = 1 * MiB;
constexpr size_t WS_WGU1 = 2 * MiB, WS_WD1 = WS_WGU1 + 172 * MiB, WS_WIN = WS_WD1 + 86 * MiB, WS_WSC = WS_WIN + 306 * MiB, WS_WSS = WS_WSC + 32 * MiB,
                 WS_WO = WS_WSS + 64 * MiB, WS_WGU2 = WS_WO + 32 * MiB, WS_WD2 = WS_WGU2 + 172 * MiB;
constexpr size_t WS_H = WS_WD2 + 86 * MiB, WS_ACT = WS_H + 64 * MiB, WS_CB = WS_ACT + 172 * MiB, WS_U = WS_CB + 64 * MiB, WS_Z = WS_U + 64 * MiB, WS_XBC = WS_Z + 128 * MiB,
                 WS_GA = WS_XBC + 160 * MiB, WS_GB = WS_GA + 64 * MiB, WS_DT = WS_GB + 64 * MiB, WS_AIN = WS_DT + 4 * MiB, WS_YG = WS_AIN + 64 * MiB, WS_T = WS_YG + 128 * MiB,
                 WS_MIX = WS_T + 128 * MiB, WS_YN = WS_MIX + 64 * MiB, WS_DTP = WS_YN + 128 * MiB, WS_END = WS_DTP + 32 * MiB;
static_assert((size_t)2 * FF * D * 2 == 172 * MiB && (size_t)D * FF * 2 == 86 * MiB && (size_t)NPROJ_PAD * D * 2 == 306 * MiB && (size_t)M * FF * 2 == 172 * MiB && (size_t)M * CONVDIM * 2 == 160 * MiB, "d_ws map");
static_assert(WS_RSQ + (size_t)4 * M * 8 + (size_t)M * 8 * 8 <= CTL_ZERO_BYTES, "row statistics inside the memset region");
static_assert(WS_END <= (size_t)2440 * MiB, "d_ws map exceeds 4 x the largest input");
constexpr int CW_BAR = 4096;

constexpr int RING_OFF = 0, RING_BYTES = 131072;
constexpr int LDS_BYTES = 163840;
constexpr int LDSCTL_OFF = LDS_BYTES - 1024, MISC_OFF = LDSCTL_OFF + 320;
constexpr int SSD_DD_OFF = RING_BYTES + 1024;
static_assert(MISC_OFF + 128 <= LDS_BYTES && SSD_DD_OFF + 1024 <= LDSCTL_OFF, "LDS map");

#define GAS __attribute__((address_space(1)))
#define LAS __attribute__((address_space(3)))
typedef unsigned short bf16;
typedef unsigned v4u __attribute__((ext_vector_type(4)));
typedef float f32x4 __attribute__((ext_vector_type(4)));
typedef short bf16x8 __attribute__((ext_vector_type(8)));
typedef GAS unsigned gu32;
typedef GAS unsigned long long gu64;
#define RLX_AGENT __ATOMIC_RELAXED, __HIP_MEMORY_SCOPE_AGENT
#define LDS_WAIT() asm volatile("s_waitcnt lgkmcnt(0)" ::: "memory")
#define VM_WAIT() asm volatile("s_waitcnt vmcnt(0)" ::: "memory")
__device__ __forceinline__ unsigned long long rt() { return __builtin_amdgcn_s_memrealtime(); }
__device__ __forceinline__ unsigned f2bf(float f) { unsigned u = __builtin_bit_cast(unsigned, f); return (u + 0x7fffu + ((u >> 16) & 1u)) >> 16; }
__device__ __forceinline__ unsigned pk2(float lo, float hi) { return f2bf(lo) | (f2bf(hi) << 16); }
#define XB_TMO      128
#define XB_XCNT(j)  (256  + 64 * (j))
#define XB_XSUB(j)  (1280 + 64 * (j))
#define XB_XGEN(j)  (2304 + 64 * (j))
#define XB_TOP      3328
#define XB_TOPGEN   3392
#define XCD_BAR_WORDS 3456
#define XB_SPIN_CAP (1u << 18)

__device__ __forceinline__ unsigned xb_ld(unsigned* p)              { return __hip_atomic_load(p, __ATOMIC_RELAXED, __HIP_MEMORY_SCOPE_AGENT); }
__device__ __forceinline__ unsigned xb_add(unsigned* p, unsigned v) { return __hip_atomic_fetch_add(p, v, __ATOMIC_RELAXED, __HIP_MEMORY_SCOPE_AGENT); }
#if XB_LOGICAL_GROUPS
__device__ __forceinline__ unsigned xb_xcc_id() { return blockIdx.x & 7u; }
#else
__device__ __forceinline__ unsigned xb_xcc_id() { return (unsigned)__builtin_amdgcn_s_getreg((3 << 11) | 20) & 0xFu; }
#endif
#define XB_SPIN(cond, bar) do { unsigned _sp = 0; while (cond) { __builtin_amdgcn_s_sleep(1); \
    if ((++_sp & 255u) == 0u) { if (xb_ld(&(bar)[XB_TMO])) break; if (_sp > XB_SPIN_CAP) { atomicAdd(&(bar)[XB_TMO], 1u); break; } } } } while (0)

struct XcdBarrier {
    unsigned* bar; unsigned x;
    volatile LAS unsigned* st;
};

__device__ __forceinline__ XcdBarrier xcd_barrier_post(unsigned* bar, volatile LAS unsigned* st) {
    XcdBarrier b; b.bar = bar; b.x = xb_xcc_id(); b.st = st;
    if (threadIdx.x == 0) (void)xb_add(&bar[XB_XCNT(b.x)], 1u);
    return b;
}
__device__ __forceinline__ void xcd_barrier_complete(unsigned* bar, unsigned x, unsigned& nloc, unsigned& nx) {
    const unsigned G = gridDim.x * gridDim.y * gridDim.z;
    unsigned sum, cnt, mine, sp = 0u;
    for (;;) {
        sum = 0u; cnt = 0u; mine = 0u;
#pragma unroll
        for (unsigned j = 0; j < 16; ++j) { const unsigned c = xb_ld(&bar[XB_XCNT(j)]); sum += c; cnt += (c > 0u) ? 1u : 0u; mine = (j == x) ? c : mine; }
        if (sum == G) break;
        __builtin_amdgcn_s_sleep(1);
        if ((++sp & 255u) == 0u) { if (xb_ld(&bar[XB_TMO])) break; if (sp > XB_SPIN_CAP) { atomicAdd(&bar[XB_TMO], 1u); break; } }
    }
    nloc = mine > 0u ? mine : 1u; nx = cnt > 0u ? cnt : 1u;
}

__device__ __forceinline__ void xcd_barrier(const XcdBarrier& b) {
    asm volatile("s_waitcnt vmcnt(0)" ::: "memory");
    __syncthreads();
    if (threadIdx.x == 0) {
        unsigned* bar = b.bar;
        __builtin_amdgcn_s_waitcnt(0);
        unsigned nloc = b.st[0], nx = b.st[1];
        if (nloc == 0u) { xcd_barrier_complete(bar, b.x, nloc, nx); b.st[0] = nloc; b.st[1] = nx; }
#if XB_EVERY_WG_RELEASE
        __builtin_amdgcn_fence(__ATOMIC_RELEASE, "agent"); asm volatile("s_waitcnt vmcnt(0)" ::: "memory");
#endif
        const unsigned old = xb_add(&bar[XB_XSUB(b.x)], 1u);
        const unsigned gen = old / nloc;
        if (old + 1u == (gen + 1u) * nloc) {
            __builtin_amdgcn_fence(__ATOMIC_RELEASE, "agent");
            asm volatile("s_waitcnt vmcnt(0)" ::: "memory");
            const unsigned og = xb_add(&bar[XB_TOP], 1u);
            const unsigned tg = og / nx;
            if (og + 1u == (tg + 1u) * nx) xb_add(&bar[XB_TOPGEN], 1u);
            else XB_SPIN(xb_ld(&bar[XB_TOPGEN]) == tg, bar);
            __builtin_amdgcn_fence(__ATOMIC_ACQUIRE, "agent");
            xb_add(&bar[XB_XGEN(b.x)], 1u);
            asm volatile("s_waitcnt vmcnt(0)" ::: "memory");
        } else {
            XB_SPIN(xb_ld(&bar[XB_XGEN(b.x)]) == gen, bar);
            __builtin_amdgcn_fence(__ATOMIC_ACQUIRE, "agent");
            asm volatile("s_waitcnt vmcnt(0)" ::: "memory");
        }
    }
    __syncthreads();
}

struct Frame {
    LAS unsigned char* lds;
    volatile LAS unsigned* MISC;
    gu32* ctl;
    int tid, lane, wave;
    int vcu, G;
};
__device__ __forceinline__ float wave_sum(float v) {
#pragma unroll
    for (int o = 1; o < 64; o <<= 1) v += __shfl_xor(v, o);
    return v;
}
typedef short v4i16_t __attribute__((ext_vector_type(4)));
__device__ __forceinline__ v4i16_t lds_tr(const LAS unsigned char* p) { return __builtin_amdgcn_ds_read_tr16_b64_v4i16((LAS v4i16_t*)p); }
__device__ __forceinline__ float bf_lo(unsigned w) { return __uint_as_float(w << 16); }
__device__ __forceinline__ float bf_hi(unsigned w) { return __uint_as_float(w & 0xffff0000u); }

__device__ __forceinline__ void p0_transpose_item(const float* W, int ld, int c0, int K, bf16* WT, int drow0, const float* nw, LAS float* scr, int kb, int lane) {
    const int k0 = 64 * kb, r = lane >> 4, c4 = lane & 15;
    f32x4 v[16];
    const float* src = W + (size_t)(k0 + r) * ld + c0 + 4 * c4;
#pragma unroll
    for (int i = 0; i < 16; ++i) v[i] = *(const GAS f32x4*)(src + (size_t)(4 * i) * ld);
    if (nw) {
#pragma unroll
        for (int i = 0; i < 16; ++i) v[i] = v[i] * nw[k0 + 4 * i + r];
    }
#pragma unroll
    for (int i = 0; i < 16; ++i) { const int k = 4 * i + r; *(LAS f32x4*)(scr + k * 64 + ((4 * c4) ^ (8 * (k >> 3)))) = v[i]; }
    LDS_WAIT(); asm volatile("" ::: "memory");
    const int c = lane >> 3, nl = lane & 7;
#pragma unroll
    for (int j = 0; j < 8; ++j) { const int n = nl + 8 * j; const LAS float* s = scr + (8 * c) * 64 + (n ^ (8 * c));
        v4u o; o.x = pg8::cvt_pk_bf16(s[0 * 64], s[1 * 64]); o.y = pg8::cvt_pk_bf16(s[2 * 64], s[3 * 64]); o.z = pg8::cvt_pk_bf16(s[4 * 64], s[5 * 64]); o.w = pg8::cvt_pk_bf16(s[6 * 64], s[7 * 64]);
        *(GAS v4u*)(WT + (size_t)(drow0 + n) * K + k0 + 8 * c) = o; }
    LDS_WAIT(); asm volatile("" ::: "memory");
}
struct Job { int in, ld, src0, ncols, K, dst0, il, nw; size_t wt; };

struct Args { const float* in[23]; float* out; unsigned char* ws; int ph_lo, ph_hi; };

__device__ __forceinline__ Job get_job(int j) {
    switch (j) {
    case 0:  return Job{2, FF, 0, FF, D, 0, 1, 1, WS_WGU1};
    case 1:  return Job{3, FF, 0, FF, D, 0, 2, 1, WS_WGU1};
    case 2:  return Job{4, D, 0, D, FF, 0, 0, -1, WS_WD1};
    case 3:  return Job{6, NPROJ, 0, 4096, D, 0, 0, 5, WS_WIN};
    case 4:  return Job{6, NPROJ, 4096, 4096, D, 4096, 1, 5, WS_WIN};
    case 5:  return Job{6, NPROJ, 8192, 4096, D, 4096, 2, 5, WS_WIN};
    case 6:  return Job{6, NPROJ, 12288, 8192, D, 12288, 0, 5, WS_WIN};
    case 7:  return Job{6, NPROJ, 20480, 10240, D, 20480, 0, 5, WS_WIN};
    case 8:  return Job{6, NPROJ, 30848, 4096, D, 30720, 0, 5, WS_WIN};
    case 9:  return Job{6, NPROJ, 34944, 4096, D, 34816, 0, 5, WS_WIN};
    case 10: return Job{6, NPROJ, 30720, 128, D, 38912, 0, 5, WS_WIN};
    case 11: return Job{9, D, 0, D, D, 0, 0, -1, WS_WSC};
    case 12: return Job{16, D, 0, D, DI, 0, 0, 15, WS_WSS};
    case 13: return Job{17, D, 0, D, D, 0, 0, -1, WS_WO};
    case 14: return Job{19, FF, 0, FF, D, 0, 1, 18, WS_WGU2};
    case 15: return Job{20, FF, 0, FF, D, 0, 2, 18, WS_WGU2};
    default: return Job{21, D, 0, D, FF, 0, 0, -1, WS_WD2};
    }
}
constexpr int NJOBS = 17;
__host__ __device__ constexpr long job_items(int ncols, int K) { return (long)(K / 64) * (ncols / 64); }

__global__ void __launch_bounds__(NWAVES * 64, 2) hyb_fwd(Args args) {
    extern __shared__ __attribute__((aligned(16))) unsigned char lds[];
    Frame F;
    F.lds = (LAS unsigned char*)lds;
    F.MISC = (volatile LAS unsigned*)(F.lds + MISC_OFF);
    F.tid = threadIdx.x; F.lane = F.tid & 63; F.wave = __builtin_amdgcn_readfirstlane(F.tid >> 6);
    F.G = gridDim.x; { const int bx = blockIdx.x; F.vcu = (F.G % 8 == 0) ? (bx % 8) * (F.G / 8) + bx / 8 : bx; }
    unsigned char* ws = args.ws;
    F.ctl = (gu32*)(ws + WS_CTL);
    for (int u = F.tid; u < (LDS_BYTES - LDSCTL_OFF) / 4; u += NWAVES * 64) ((LAS unsigned*)(F.lds + LDSCTL_OFF))[u] = 0u;
    __syncthreads();
    XcdBarrier bar; bar.bar = (unsigned*)(F.ctl + CW_BAR); bar.x = 0; bar.st = nullptr;
    if (N_LAUNCHES == 1 && USE_CG_SYNC != 1) bar = xcd_barrier_post((unsigned*)(F.ctl + CW_BAR), F.MISC + 8);
#if USE_CG_SYNC == 1
#define GRID_BAR() do { if (N_LAUNCHES == 1) cooperative_groups::this_grid().sync(); } while (0)
#else
#define GRID_BAR() do { if (N_LAUNCHES == 1) xcd_barrier(bar); } while (0)
#endif
#if USE_CG_SYNC == 2
    if (N_LAUNCHES == 1) cooperative_groups::this_grid().sync();
#endif
    const int lo = args.ph_lo, hi = args.ph_hi;
#define IN(k) (lo <= (k) && (k) < hi)
#define BOTH(k) (IN(k) && IN((k) + 1))
    const float* x_in = args.in[0];
    float* xres = args.out;
    bf16* Hb = (bf16*)(ws + WS_H); bf16* ACT = (bf16*)(ws + WS_ACT);
    bf16* CBb = (bf16*)(ws + WS_CB); bf16* Ub = (bf16*)(ws + WS_U); bf16* Zb = (bf16*)(ws + WS_Z); bf16* XBCb = (bf16*)(ws + WS_XBC);
    bf16* GAb = (bf16*)(ws + WS_GA); bf16* GBb = (bf16*)(ws + WS_GB); const float* DTP = (const float*)(ws + WS_DTP);
    bf16* AIN = (bf16*)(ws + WS_AIN); bf16* YG = (bf16*)(ws + WS_YG); float* Tb = (float*)(ws + WS_T); bf16* MIX = (bf16*)(ws + WS_MIX); bf16* YN = (bf16*)(ws + WS_YN);
    unsigned long long* RSQ1 = (unsigned long long*)(ws + WS_RSQ); unsigned long long* RSQ2 = RSQ1 + M; unsigned long long* RSQ3 = RSQ2 + M; unsigned long long* RSQ4 = RSQ3 + M;
    unsigned long long* GSQ = RSQ4 + M;
    const int gw = F.vcu * NWAVES + F.wave, NGW = F.G * NWAVES;

    if (IN(0)) for (int prep_ = 0; prep_ < (PROBE_DUP == 0 ? 2 : 1); ++prep_) {
        if (prep_) __syncthreads();
        LAS float* scr = (LAS float*)(F.lds + RING_OFF + F.wave * 16384);
        long base = 0;
        for (int j = 0; j < NJOBS; ++j) {
            const Job jb = get_job(j); const int nblk = jb.ncols / 64; const long nit = job_items(jb.ncols, jb.K);
            const float* W = args.in[jb.in]; const float* nw = jb.nw >= 0 ? args.in[jb.nw] : nullptr; bf16* WT = (bf16*)(ws + jb.wt);
            long first = (long)gw - (base % NGW); if (first < 0) first += NGW;
            for (long it = first; it < nit; it += NGW) {
                const int kb = (int)(it / nblk), nb = (int)(it % nblk), c = 64 * nb;
                const int drow = jb.il == 0 ? jb.dst0 + c : jb.dst0 + (c >> 7) * 256 + (c & 127) + (jb.il == 2 ? 128 : 0);
                p0_transpose_item(W, jb.ld, jb.src0 + c, jb.K, WT, drow, nw, scr, kb, F.lane);
            }
            base += nit;
        }
        {
            v4u* z = (v4u*)((bf16*)(ws + WS_WIN) + (size_t)39040 * D); const size_t n16 = (size_t)128 * D * 2 / 16;
            for (size_t i = (size_t)blockIdx.x * (NWAVES * 64) + F.tid; i < n16; i += (size_t)F.G * NWAVES * 64) z[i] = (v4u){0u, 0u, 0u, 0u};
        }
        for (int m = gw; m < M; m += NGW) {
            const GAS f32x4* xr = (const GAS f32x4*)(x_in + (size_t)m * D) + F.lane; GAS unsigned long long* o8 = (GAS unsigned long long*)(Hb + (size_t)m * D) + F.lane; float s = 0.f;
#pragma unroll
            for (int j = 0; j < 16; ++j) { const f32x4 v = xr[64 * j]; s += (v.x * v.x + v.y * v.y) + (v.z * v.z + v.w * v.w);
                o8[64 * j] = (unsigned long long)pg8::cvt_pk_bf16(v.x, v.y) | ((unsigned long long)pg8::cvt_pk_bf16(v.z, v.w) << 32); }
            s = wave_sum(s);
            if (F.lane == 0) RSQ1[m] = pg8::rsq_fix(s);
        }
    }
    if (BOTH(0)) GRID_BAR();
    if (IN(1)) {
        pg8::Gemm g{Hb, (const bf16*)(ws + WS_WGU1), M, 2 * FF, D, D}; pg8::StaticOrder S; S.init(M, 2 * FF, F.G, (int)blockIdx.x);
        pg8::EpiGateUp E{ACT, FF, RSQ1, 1.0f / D};
        pg8::gemm_phase<pg8::EpiGateUp, pg8::StaticOrder, PG8_ALIGN, PG8_SP2>(F.lds + RING_OFF, g, S, E);
    }
#if PROBE_DUP == 1
    if (IN(1)) {
        pg8::Gemm g{Hb, (const bf16*)(ws + WS_WGU1), M, 2 * FF, D, D}; pg8::StaticOrder S; S.init(M, 2 * FF, F.G, (int)blockIdx.x);
        pg8::EpiGateUp E{ACT, FF, RSQ1, 1.0f / D};
        pg8::gemm_phase<pg8::EpiGateUp, pg8::StaticOrder, PG8_ALIGN, PG8_SP2>(F.lds + RING_OFF, g, S, E);
    }
#endif
#if PROBE_DUP == 101
    if (IN(1)) {
        pg8::Gemm g{Hb, (const bf16*)(ws + WS_WGU1), M, 2 * FF, D, D}; pg8::ProbeOrder S; S.init(M, 2 * FF, F.G, (int)blockIdx.x);
        pg8::EpiGateUp E{(bf16*)(ws + WS_T), FF, RSQ1, 1.0f / D};
        pg8::gemm_phase<pg8::EpiGateUp, pg8::ProbeOrder, PG8_ALIGN, PG8_SP2>(F.lds + RING_OFF, g, S, E);
    }
#endif
    if (BOTH(1)) GRID_BAR();
    if (IN(2)) {
        pg8::Gemm g{ACT, (const bf16*)(ws + WS_WD1), M, D, FF, FF}; pg8::StaticOrder S; S.init(M, D, F.G, (int)blockIdx.x);
        pg8::EpiResid<true> E{x_in, xres, Hb, RSQ2, 0.5f, D};
        pg8::gemm_phase<pg8::EpiResid<true>, pg8::StaticOrder, PG8_ALIGN, PG8_SP2>(F.lds + RING_OFF, g, S, E);
    }
#if PROBE_DUP == 2
    if (IN(2)) {
        pg8::Gemm g{ACT, (const bf16*)(ws + WS_WD1), M, D, FF, FF}; pg8::StaticOrder S; S.init(M, D, F.G, (int)blockIdx.x);
        pg8::EpiResid<true> E{x_in, xres, Hb, (unsigned long long*)(ws + WS_T), 0.5f, D};
        pg8::gemm_phase<pg8::EpiResid<true>, pg8::StaticOrder, PG8_ALIGN, PG8_SP2>(F.lds + RING_OFF, g, S, E);
    }
#endif
    if (IN(2)) {
        if (BOTH(2)) GRID_BAR();
    }
    if (IN(3)) {
        pg8::Gemm g{Hb, (const bf16*)(ws + WS_WIN), M, NPROJ_MAIN, D, D}; pg8::StaticOrder S; S.init(M, NPROJ_MAIN, F.G, (int)blockIdx.x);
        pg8::EpiProj E{CBb, Ub, Zb, XBCb, GAb, GBb, args.in[7], RSQ2, 1.0f / D};
        pg8::gemm_phase<pg8::EpiProj, pg8::StaticOrder, PG8_ALIGN, PG8_SP2>(F.lds + RING_OFF, g, S, E);
        {
            const int item = (int)blockIdx.x, pm = item & 31, ks = item >> 5;
            if (item < 32 * DT_KS) {
                pg8::Gemm gd{Hb + ks * (D / DT_KS), (const bf16*)(ws + WS_WIN) + (size_t)NPROJ_MAIN * D + ks * (D / DT_KS), M, 256, D / DT_KS, D}; pg8::OneUnit S1{pm};
                pg8::EpiDtPart E1{(float*)(ws + WS_DTP) + (size_t)ks * M * 128};
                pg8::gemm_phase<pg8::EpiDtPart, pg8::OneUnit, false, PG8_SP2>(F.lds + RING_OFF, gd, S1, E1);
            }
        }
        if (BOTH(3)) GRID_BAR();
    }
    if (IN(4)) for (int prep_ = 0; prep_ < (PROBE_DUP == 4 ? 2 : 1); ++prep_) {
        unsigned long long* GSQw = prep_ ? (unsigned long long*)(ws + WS_T) : GSQ;
        {
            const float* cw = args.in[8]; const int c8 = F.tid * 8;
            float w0[8], w1[8], w2[8];
#pragma unroll
            for (int i = 0; i < 8; ++i) { w0[i] = cw[c8 + i]; w1[i] = cw[4096 + c8 + i]; w2[i] = cw[8192 + c8 + i]; }
            for (int strip = blockIdx.x; strip < M / 32; strip += F.G) {
                const int r0 = strip * 32; v4u um2 = (v4u){0u, 0u, 0u, 0u}, um1 = um2;
                if ((r0 % SEQ) != 0) { um2 = *(const v4u*)(Ub + (size_t)(r0 - 2) * 4096 + c8); um1 = *(const v4u*)(Ub + (size_t)(r0 - 1) * 4096 + c8); }
#pragma unroll 4
                for (int r = r0; r < r0 + 32; ++r) {
                    const v4u u0 = *(const v4u*)(Ub + (size_t)r * 4096 + c8), cb = *(const v4u*)(CBb + (size_t)r * 4096 + c8);
                    const unsigned a[4] = {um2.x, um2.y, um2.z, um2.w}, b[4] = {um1.x, um1.y, um1.z, um1.w}, c[4] = {u0.x, u0.y, u0.z, u0.w}, d[4] = {cb.x, cb.y, cb.z, cb.w};
                    unsigned o[4];
#pragma unroll
                    for (int q = 0; q < 4; ++q) {
                        const float lo_ = bf_lo(d[q]) * (w0[2 * q] * bf_lo(a[q]) + w1[2 * q] * bf_lo(b[q]) + w2[2 * q] * bf_lo(c[q]));
                        const float hi_ = bf_hi(d[q]) * (w0[2 * q + 1] * bf_hi(a[q]) + w1[2 * q + 1] * bf_hi(b[q]) + w2[2 * q + 1] * bf_hi(c[q]));
                        o[q] = pg8::cvt_pk_bf16(lo_, hi_); }
                    *(v4u*)(AIN + (size_t)r * 4096 + c8) = (v4u){o[0], o[1], o[2], o[3]};
                    um2 = um1; um1 = u0;
                }
            }
        }
        {
            constexpr int P = 272, PX = 144, YP = 68;
            constexpr int C_OFF = 0, B_OFF = 128 * P, X_OFF = 2 * 128 * P, PS_OFF = X_OFF + 128 * PX, F_OFF = PS_OFF + 64 * P, Y_OFF = F_OFF + 2048, CW_OFF = Y_OFF + 128 * YP * 4, DTA_OFF = CW_OFF + 5 * 320 * 4;
            static_assert(Y_OFF % 16 == 0 && CW_OFF % 16 == 0 && DTA_OFF + SEQ * 4 <= LDSCTL_OFF, "SSD LDS map");
            LAS unsigned char* const L = F.lds;
            LAS float* const dt_s = (LAS float*)(L + F_OFF); LAS float* const acs_s = dt_s + 128; LAS float* const wd_s = dt_s + 256;
            LAS float* const Ys = (LAS float*)(L + Y_OFF);
            LAS float* const dtall = (LAS float*)(L + DTA_OFF);
            LAS float* const cwl = (LAS float*)(L + CW_OFF);
            const float* convw = args.in[10]; const float* convb = args.in[11];
            const int w = F.wave;
            const int cg = F.tid & 31, ts = F.tid >> 5;
            const int xcg = F.tid & 7, xts = F.tid >> 3;
            for (int unit = blockIdx.x; unit < BATCH * NH; unit += F.G) {
                const int b = unit / NH, h = unit % NH, g = h >> 4;
                const float Ah = -__expf(args.in[13][h]), Dh = args.in[14][h];
                const int bc_col = cg < 16 ? DI + g * 128 + cg * 8 : DI + 1024 + g * 128 + (cg - 16) * 8;
                const int x_col = h * 64 + xcg * 8;
                const int bc_l = cg < 16 ? cg * 8 : 128 + (cg - 16) * 8, x_l = 256 + xcg * 8;
                __syncthreads();
                for (int i = F.tid; i < 5 * 320; i += NWAVES * 64) { const int k = i / 320, c = i % 320;
                    const int col = c < 128 ? DI + g * 128 + c : c < 256 ? DI + 1024 + g * 128 + (c - 128) : h * 64 + (c - 256);
                    cwl[i] = k < 4 ? convw[k * CONVDIM + col] : convb[col]; }
                for (int i = F.tid; i < SEQ; i += NWAVES * 64) { const size_t row = (size_t)b * SEQ + i; float sacc = 0.f;
#pragma unroll
                    for (int ks = 0; ks < DT_KS; ++ks) sacc += DTP[((size_t)ks * M + row) * 128 + h];
                    const float v = sacc * pg8::rstd_of(RSQ2, (int)row, 1.0f / D, pg8::RMS_EPS_F) + args.in[12][h];
                    dtall[i] = fmaxf(v, 0.f) + log1pf(__expf(-fabsf(v))); }
                pg8::f32x4 Sacc[4];
#pragma unroll
                for (int t = 0; t < 4; ++t) Sacc[t] = (pg8::f32x4){0.f, 0.f, 0.f, 0.f};
                for (int i = F.tid; i < 64 * P / 16; i += NWAVES * 64) ((LAS v4u*)(L + PS_OFF))[i] = (v4u){0u, 0u, 0u, 0u};
                v4u rawA[11], rawX[5];
#define SSD_LOAD_RAW(T0) do { \
    _Pragma("unroll") for (int j = 0; j < 11; ++j) { const int tl = (T0) + ts * 8 - 3 + j; \
        rawA[j] = tl >= 0 ? *(const v4u*)(XBCb + ((size_t)b * SEQ + tl) * CONVDIM + bc_col) : (v4u){0u, 0u, 0u, 0u}; } \
    _Pragma("unroll") for (int j = 0; j < 5; ++j) { const int tl = (T0) + xts * 2 - 3 + j; \
        rawX[j] = tl >= 0 ? *(const v4u*)(XBCb + ((size_t)b * SEQ + tl) * CONVDIM + x_col) : (v4u){0u, 0u, 0u, 0u}; } } while (0)
                SSD_LOAD_RAW(0);
                for (int ch = 0; ch < SEQ / 128; ++ch) {
                    const int t0 = ch * 128; const size_t row0 = (size_t)b * SEQ + t0;
                    int l = F.lane; asm volatile("" : "+v"(l));
                    const int g4 = l >> 4, li = l & 15, q4 = li >> 2, p4 = li & 3;
                    __syncthreads();
                    {
                        {
                            float cw[4][8], cbias[8];
#pragma unroll
                            for (int k = 0; k < 4; ++k) { const pg8::f32x4 u0 = *(const LAS pg8::f32x4*)(cwl + k * 320 + bc_l), u1 = *(const LAS pg8::f32x4*)(cwl + k * 320 + bc_l + 4);
#pragma unroll
                                for (int i = 0; i < 4; ++i) { cw[k][i] = u0[i]; cw[k][4 + i] = u1[i]; } }
                            { const pg8::f32x4 u0 = *(const LAS pg8::f32x4*)(cwl + 4 * 320 + bc_l), u1 = *(const LAS pg8::f32x4*)(cwl + 4 * 320 + bc_l + 4);
#pragma unroll
                                for (int i = 0; i < 4; ++i) { cbias[i] = u0[i]; cbias[4 + i] = u1[i]; } }
                            LAS unsigned char* dst = L + (cg < 16 ? B_OFF + cg * 16 : C_OFF + (cg - 16) * 16);
#pragma unroll
                            for (int r = 0; r < 8; ++r) { float o[8];
#pragma unroll
                                for (int i = 0; i < 8; ++i) o[i] = cbias[i];
#pragma unroll
                                for (int k = 0; k < 4; ++k) { const v4u ww_ = rawA[r + k]; const unsigned ww[4] = {ww_.x, ww_.y, ww_.z, ww_.w};
#pragma unroll
                                    for (int q = 0; q < 4; ++q) { o[2 * q] += cw[k][2 * q] * bf_lo(ww[q]); o[2 * q + 1] += cw[k][2 * q + 1] * bf_hi(ww[q]); } }
#pragma unroll
                                for (int i = 0; i < 8; ++i) o[i] = pg8::fast_silu(o[i]);
                                *(LAS v4u*)(dst + (ts * 8 + r) * P) = pg8::pack8((pg8::f32x4){o[0], o[1], o[2], o[3]}, (pg8::f32x4){o[4], o[5], o[6], o[7]}); }
                        }
                        {
                            float cw[4][8], cbias[8];
#pragma unroll
                            for (int k = 0; k < 4; ++k) { const pg8::f32x4 u0 = *(const LAS pg8::f32x4*)(cwl + k * 320 + x_l), u1 = *(const LAS pg8::f32x4*)(cwl + k * 320 + x_l + 4);
#pragma unroll
                                for (int i = 0; i < 4; ++i) { cw[k][i] = u0[i]; cw[k][4 + i] = u1[i]; } }
                            { const pg8::f32x4 u0 = *(const LAS pg8::f32x4*)(cwl + 4 * 320 + x_l), u1 = *(const LAS pg8::f32x4*)(cwl + 4 * 320 + x_l + 4);
#pragma unroll
                                for (int i = 0; i < 4; ++i) { cbias[i] = u0[i]; cbias[4 + i] = u1[i]; } }
                            LAS unsigned char* xdst = L + X_OFF + xcg * 16;
#pragma unroll
                            for (int r = 0; r < 2; ++r) { float o[8];
#pragma unroll
                                for (int i = 0; i < 8; ++i) o[i] = cbias[i];
#pragma unroll
                                for (int k = 0; k < 4; ++k) { const v4u ww_ = rawX[r + k]; const unsigned ww[4] = {ww_.x, ww_.y, ww_.z, ww_.w};
#pragma unroll
                                    for (int q = 0; q < 4; ++q) { o[2 * q] += cw[k][2 * q] * bf_lo(ww[q]); o[2 * q + 1] += cw[k][2 * q + 1] * bf_hi(ww[q]); } }
#pragma unroll
                                for (int i = 0; i < 8; ++i) o[i] = pg8::fast_silu(o[i]);
                                *(LAS v4u*)(xdst + (xts * 2 + r) * PX) = pg8::pack8((pg8::f32x4){o[0], o[1], o[2], o[3]}, (pg8::f32x4){o[4], o[5], o[6], o[7]}); }
                        }
                        if (F.tid >= 128 && F.tid < 256) {
                            const float d_lo = dtall[t0 + l], d_hi = dtall[t0 + 64 + l];
                            const float a_lo = d_lo * Ah, a_hi = d_hi * Ah;
                            const float tot_lo = wave_sum(a_lo), tot = tot_lo + wave_sum(a_hi);
                            const bool hiw = (w == 3);
                            float v = hiw ? a_hi : a_lo;
#pragma unroll
                            for (int d = 1; d < 64; d <<= 1) { const float u = __shfl_up(v, d); if (l >= d) v += u; }
                            if (hiw) v += tot_lo;
                            const int t = F.tid - 128; const float dtv = hiw ? d_hi : d_lo;
                            dt_s[t] = dtv; acs_s[t] = v; wd_s[t] = dtv * __expf(tot - v);
                        }
                    }
                    __syncthreads();
                    if (ch + 1 < SEQ / 128) SSD_LOAD_RAW(t0 + 128);
                    const size_t zrow = row0 + (F.tid >> 2);
                    const v4u z0 = *(const v4u*)(Zb + zrow * DI + h * 64 + (F.tid & 3) * 16), z1 = *(const v4u*)(Zb + zrow * DI + h * 64 + (F.tid & 3) * 16 + 8);
                    pg8::bf16x8 Cf[4];
#pragma unroll
                    for (int ks = 0; ks < 4; ++ks) Cf[ks] = *(const LAS pg8::bf16x8*)(L + C_OFF + (16 * w + li) * P + (32 * ks + 8 * g4) * 2);
                    const float acs_i = acs_s[16 * w + li];
                    pg8::f32x4 yd[4], yo[4];
#pragma unroll
                    for (int pt = 0; pt < 4; ++pt) { yd[pt] = (pg8::f32x4){0.f, 0.f, 0.f, 0.f}; yo[pt] = (pg8::f32x4){0.f, 0.f, 0.f, 0.f}; }
#pragma unroll
                    for (int k2 = 0; k2 < 4; ++k2) {
                        if (2 * k2 <= w) {
                            pg8::f32x4 sv[2];
#pragma unroll
                            for (int u = 0; u < 2; ++u) {
                                const int jt = 2 * k2 + u;
                                sv[u] = (pg8::f32x4){0.f, 0.f, 0.f, 0.f};
                                if (jt <= w) {
                                    pg8::f32x4 cb = (pg8::f32x4){0.f, 0.f, 0.f, 0.f};
#pragma unroll
                                    for (int ks = 0; ks < 4; ++ks) { const pg8::bf16x8 bf = *(const LAS pg8::bf16x8*)(L + B_OFF + (16 * jt + li) * P + (32 * ks + 8 * g4) * 2);
                                        cb = __builtin_amdgcn_mfma_f32_16x16x32_bf16(bf, Cf[ks], cb, 0, 0, 0); }
                                    const pg8::f32x4 aj = *(const LAS pg8::f32x4*)(acs_s + 16 * jt + 4 * g4), dj = *(const LAS pg8::f32x4*)(dt_s + 16 * jt + 4 * g4);
#pragma unroll
                                    for (int r = 0; r < 4; ++r) { const bool ok = (jt < w) || (4 * g4 + r <= li); const float e = ok ? __expf(acs_i - aj[r]) : 0.f; sv[u][r] = cb[r] * e * dj[r]; }
                                }
                            }
                            const pg8::bf16x8 Sf = __builtin_bit_cast(pg8::bf16x8, pg8::pack8(sv[0], sv[1]));
#pragma unroll
                            for (int pt = 0; pt < 4; ++pt) {
                                const LAS unsigned char* xa = L + X_OFF + (32 * k2 + 4 * g4 + q4) * PX + (16 * pt + 4 * p4) * 2;
                                const pg8::bf16x8 Xf = __builtin_shufflevector(lds_tr(xa), lds_tr(xa + 16 * PX), 0, 1, 2, 3, 4, 5, 6, 7);
                                yd[pt] = __builtin_amdgcn_mfma_f32_16x16x32_bf16(Sf, Xf, yd[pt], 0, 0, 0); }
                        }
                    }
#pragma unroll
                    for (int pt = 0; pt < 4; ++pt)
#pragma unroll
                        for (int ks = 0; ks < 4; ++ks) { const pg8::bf16x8 pf = *(const LAS pg8::bf16x8*)(L + PS_OFF + (16 * pt + li) * P + (32 * ks + 8 * g4) * 2);
                            yo[pt] = __builtin_amdgcn_mfma_f32_16x16x32_bf16(Cf[ks], pf, yo[pt], 0, 0, 0); }
                    {
                        const pg8::f32x4 ai = *(const LAS pg8::f32x4*)(acs_s + 16 * w + 4 * g4);
#pragma unroll
                        for (int r = 0; r < 4; ++r) { const float ei = __expf(ai[r]);
#pragma unroll
                            for (int pt = 0; pt < 4; ++pt) Ys[(16 * w + 4 * g4 + r) * YP + 16 * pt + li] = yd[pt][r] + ei * yo[pt][r]; }
                    }
                    {
                        const float dec = __expf(acs_s[127]); const int spt = w & 3, snt0 = 4 * (w >> 2);
#pragma unroll
                        for (int t = 0; t < 4; ++t) Sacc[t] = Sacc[t] * dec;
#pragma unroll
                        for (int ks = 0; ks < 4; ++ks) {
                            const LAS unsigned char* xa = L + X_OFF + (32 * ks + 8 * g4 + q4) * PX + (16 * spt + 4 * p4) * 2;
                            const pg8::u32x4 xr = __builtin_bit_cast(pg8::u32x4, (pg8::bf16x8)__builtin_shufflevector(lds_tr(xa), lds_tr(xa + 4 * PX), 0, 1, 2, 3, 4, 5, 6, 7));
                            pg8::f32x4 xl, xh; pg8::unpack8(xr, xl, xh);
                            const pg8::f32x4 wl = *(const LAS pg8::f32x4*)(wd_s + 32 * ks + 8 * g4), wh = *(const LAS pg8::f32x4*)(wd_s + 32 * ks + 8 * g4 + 4);
                            const pg8::bf16x8 Xw = __builtin_bit_cast(pg8::bf16x8, pg8::pack8(xl * wl, xh * wh));
#pragma unroll
                            for (int t = 0; t < 4; ++t) {
                                const LAS unsigned char* ba = L + B_OFF + (32 * ks + 8 * g4 + q4) * P + (16 * (snt0 + t) + 4 * p4) * 2;
                                const pg8::bf16x8 Bf = __builtin_shufflevector(lds_tr(ba), lds_tr(ba + 4 * P), 0, 1, 2, 3, 4, 5, 6, 7);
                                Sacc[t] = __builtin_amdgcn_mfma_f32_16x16x32_bf16(Xw, Bf, Sacc[t], 0, 0, 0); }
                        }
                    }
                    __syncthreads();
                    {
                        const int spt = w & 3, snt0 = 4 * (w >> 2);
#pragma unroll
                        for (int t = 0; t < 4; ++t)
#pragma unroll
                            for (int r = 0; r < 4; ++r) *(LAS unsigned short*)(L + PS_OFF + (16 * spt + 4 * g4 + r) * P + (16 * (snt0 + t) + li) * 2) = (unsigned short)(pg8::cvt_pk_bf16(Sacc[t][r], 0.f) & 0xffffu);
                    }
                    {
                        const int row = F.tid >> 2, seg = F.tid & 3; const size_t grow = row0 + row;
                        const LAS pg8::f32x4* yp = (const LAS pg8::f32x4*)(Ys + row * YP + seg * 16);
                        const LAS v4u* xp = (const LAS v4u*)(L + X_OFF + row * PX + seg * 32);
                        pg8::f32x4 za, zb, zc, zd, xa_, xb_, xc_, xd_; pg8::unpack8(z0, za, zb); pg8::unpack8(z1, zc, zd); pg8::unpack8(xp[0], xa_, xb_); pg8::unpack8(xp[1], xc_, xd_);
                        const pg8::f32x4 v0 = (yp[0] + xa_ * Dh) * za, v1 = (yp[1] + xb_ * Dh) * zb, v2 = (yp[2] + xc_ * Dh) * zc, v3 = (yp[3] + xd_ * Dh) * zd;
                        float ss = 0.f;
#pragma unroll
                        for (int i = 0; i < 4; ++i) ss += (v0[i] * v0[i] + v1[i] * v1[i]) + (v2[i] * v2[i] + v3[i] * v3[i]);
                        *(v4u*)(YG + grow * DI + h * 64 + seg * 16) = pg8::pack8(v0, v1); *(v4u*)(YG + grow * DI + h * 64 + seg * 16 + 8) = pg8::pack8(v2, v3);
                        ss += __shfl_xor(ss, 1); ss += __shfl_xor(ss, 2);
                        if (seg == 0) atomicAdd(GSQw + grow * 8 + g, pg8::rsq_fix(ss));
                    }
                }
            }
        }
#undef SSD_LOAD_RAW
    }
    if (BOTH(4)) GRID_BAR();
    if (IN(5)) {
        for (int m = gw; m < M; m += NGW) {
            const GAS v4u* yr = (const GAS v4u*)(YG + (size_t)m * DI) + F.lane; GAS v4u* yo = (GAS v4u*)(YN + (size_t)m * DI) + F.lane;
#pragma unroll 4
            for (int j = 0; j < 16; ++j) { const float rs = pg8::rstd_of(GSQ, m * 8 + (j >> 1), 1.0f / 1024.0f, pg8::RMS_EPS_F);
                const v4u w = yr[64 * j]; f32x4 a, b2; pg8::unpack8(w, a, b2); yo[64 * j] = pg8::pack8(a * rs, b2 * rs); }
        }
    }
    if (IN(6)) {
        pg8::Gemm g{AIN, (const bf16*)(ws + WS_WSC), M, D, D, D}; pg8::StaticOrder S; S.init(M, D, F.G, (int)blockIdx.x);
        pg8::EpiScA E{GAb, Tb};
        pg8::gemm_phase<pg8::EpiScA, pg8::StaticOrder, PG8_ALIGN, PG8_SP2>(F.lds + RING_OFF, g, S, E);
        if (BOTH(6)) GRID_BAR();
    }
    if (IN(7)) {
        pg8::Gemm g{YN, (const bf16*)(ws + WS_WSS), M, D, DI, DI}; pg8::StaticOrder S; S.init(M, D, F.G, (int)blockIdx.x);
        pg8::EpiSsB E{GBb, Tb, MIX};
        pg8::gemm_phase<pg8::EpiSsB, pg8::StaticOrder, PG8_ALIGN, PG8_SP2>(F.lds + RING_OFF, g, S, E);
        if (BOTH(7)) GRID_BAR();
    }
    if (IN(8)) {
        pg8::Gemm g{MIX, (const bf16*)(ws + WS_WO), M, D, D, D}; pg8::StaticOrder S; S.init(M, D, F.G, (int)blockIdx.x);
        pg8::EpiResid<true> E{xres, xres, Hb, RSQ3, 1.0f, D};
        pg8::gemm_phase<pg8::EpiResid<true>, pg8::StaticOrder, PG8_ALIGN, PG8_SP2>(F.lds + RING_OFF, g, S, E);
        if (BOTH(8)) GRID_BAR();
    }
    if (IN(9)) {
        pg8::Gemm g{Hb, (const bf16*)(ws + WS_WGU2), M, 2 * FF, D, D}; pg8::StaticOrder S; S.init(M, 2 * FF, F.G, (int)blockIdx.x);
        pg8::EpiGateUp E{ACT, FF, RSQ3, 1.0f / D};
        pg8::gemm_phase<pg8::EpiGateUp, pg8::StaticOrder, PG8_ALIGN, PG8_SP2>(F.lds + RING_OFF, g, S, E);
        if (BOTH(9)) GRID_BAR();
    }
    if (IN(10)) {
        pg8::Gemm g{ACT, (const bf16*)(ws + WS_WD2), M, D, FF, FF}; pg8::StaticOrder S; S.init(M, D, F.G, (int)blockIdx.x);
        pg8::EpiResid<false> E{xres, xres, nullptr, RSQ4, 0.5f, D};
        pg8::gemm_phase<pg8::EpiResid<false>, pg8::StaticOrder, PG8_ALIGN, PG8_SP2>(F.lds + RING_OFF, g, S, E);
        if (BOTH(10)) GRID_BAR();
    }
#if PROBE_SYNCS
    for (int i_ = 0; i_ < PROBE_SYNCS; ++i_) GRID_BAR();
#endif
    if (IN(11)) {
        const float* fw = args.in[22];
        for (int m = gw; m < M; m += NGW) {
            const float rs = pg8::rstd_of(RSQ4, m, 1.0f / D, pg8::RMS_EPS_F);
            GAS f32x4* xr = (GAS f32x4*)(xres + (size_t)m * D) + F.lane; const f32x4* wr4 = (const f32x4*)fw + F.lane;
#pragma unroll 4
            for (int j = 0; j < 16; ++j) { const f32x4 v = xr[64 * j]; xr[64 * j] = v * rs * wr4[64 * j]; }
        }
    }
#undef IN
#undef BOTH
#undef GRID_BAR
}

extern "C" void kernel_launch(void* const* d_in, const int* in_sizes, int n_in, void* d_out, int out_size, void* d_ws, size_t ws_size, hipStream_t stream) {
    static int grid = 0;
    if (grid == 0) {
        if (n_in != 23 || in_sizes[0] != M * D || out_size != M * D || ws_size < WS_END) { fprintf(stderr, "kernel_launch: unexpected shapes / workspace (n_in %d, in0 %d, out %d, ws %zu, need %zu); nothing launched\n", n_in, n_in > 0 ? in_sizes[0] : -1, out_size, ws_size, (size_t)WS_END); grid = -1; return; }
        int dev = 0, cus = 0, per_cu = 0;
        if (hipGetDevice(&dev) != hipSuccess || hipDeviceGetAttribute(&cus, hipDeviceAttributeMultiprocessorCount, dev) != hipSuccess) { grid = -1; return; }
        if (hipFuncSetAttribute((const void*)hyb_fwd, hipFuncAttributeMaxDynamicSharedMemorySize, LDS_BYTES) != hipSuccess) { fprintf(stderr, "kernel_launch: hipFuncSetAttribute failed\n"); grid = -1; return; }
        if (hipOccupancyMaxActiveBlocksPerMultiprocessor(&per_cu, (const void*)hyb_fwd, NWAVES * 64, LDS_BYTES) != hipSuccess || per_cu < 1)
            fprintf(stderr, "kernel_launch: note: occupancy query reports %d workgroups per CU\n", per_cu);
        (void)hipGetLastError();
        if (cus != 256) { fprintf(stderr, "kernel_launch: built for a 256-CU device (got %d)\n", cus); grid = -1; return; }
        grid = cus;
    }
    if (grid < 0) return;
    if (hipMemsetAsync((char*)d_ws + WS_CTL, 0, CTL_ZERO_BYTES, stream) != hipSuccess) { fprintf(stderr, "kernel_launch: memset failed\n"); return; }
    Args a{};
    for (int i = 0; i < 23; ++i) a.in[i] = (const float*)d_in[i];
    a.out = (float*)d_out; a.ws = (unsigned char*)d_ws;
    for (int li = 0; li < N_LAUNCHES; ++li) {
        a.ph_lo = (N_LAUNCHES == 1) ? 0 : li; a.ph_hi = (N_LAUNCHES == 1) ? NPHASE : li + 1;
        hipError_t le;
        if (N_LAUNCHES == 1 && USE_CG_SYNC) { void* kargs[] = {(void*)&a}; le = hipLaunchCooperativeKernel((const void*)hyb_fwd, dim3(grid), dim3(NWAVES * 64), kargs, LDS_BYTES, stream); }
        else { hipLaunchKernelGGL(hyb_fwd, dim3(grid), dim3(NWAVES * 64), LDS_BYTES, stream, a); le = hipPeekAtLastError(); }
        if (le != hipSuccess) { fprintf(stderr, "kernel_launch: launch %d failed: %s\n", li, hipGetErrorName(le)); break; }
    }
}
```

```cpp
#include <hip/hip_runtime.h>
#include <hip/hip_cooperative_groups.h>
#include <cstdio>
#include <cstdint>
namespace pg8 {
#define PG8_LAS __attribute__((address_space(3)))
typedef unsigned short bf16_t;
typedef short bf16x8 __attribute__((ext_vector_type(8)));
typedef float f32x4 __attribute__((ext_vector_type(4)));
typedef unsigned u32x4 __attribute__((ext_vector_type(4)));
constexpr int BM = 256, BK = 64, HALF = 128, HTB = HALF * BK * 2  , STAGE_BYTES = 8 * HTB, NXCD = 8, WGM = 8;

__host__ __device__ __forceinline__ int lds_byte(int r, int c) { const int st = (r >> 4) * 2 + (c >> 5), rr = r & 15, cc = c & 31, ob = rr * 64 + cc * 2; return st * 1024 + (ob ^ (((ob >> 9) & 1) << 5)); }
__host__ __device__ __forceinline__ void stage_rc(int b, int& R, int& C) { const int st = b / 1024, sb = b % 1024, swz = sb ^ (((sb >> 9) & 1) << 5); R = (st >> 1) * 16 + swz / 64; C = (st & 1) * 32 + (swz % 64) / 2; }
__host__ __device__ __forceinline__ int perm32(int rho) { const int n = rho >> 4, i = rho & 15; return 8 * (i >> 2) + 4 * n + (i & 3); }

struct Unit { int pm, pn; };
struct Gemm { const bf16_t* A; const bf16_t* Bt; int M, N, K, ld; };

struct StaticOrder {
    int nM, nN, nwg, G, c;
    __host__ __device__ void init(int M, int N, int G_, int c_) { nM = M / BM; nN = N / BM; nwg = nM * nN; G = G_; c = c_; }
    __host__ __device__ bool next(int i, Unit& u) const {
        const long L = (long)i * G + c; if (L >= nwg) return false;
        int wgid = (int)L; { const int q = nwg / NXCD, r = nwg % NXCD, xcd = wgid % NXCD, off = wgid / NXCD; wgid = (xcd < r ? xcd * (q + 1) : r * (q + 1) + (xcd - r) * q) + off; }
        const int nig = WGM * nN, gid = wgid / nig, fm = gid * WGM, gsz = (nM - fm) < WGM ? (nM - fm) : WGM;
        u.pm = fm + ((wgid % nig) % gsz); u.pn = (wgid % nig) / gsz; return true;
    }
    __device__ __forceinline__ void a_ready(const Unit&) const {}
    __device__ __forceinline__ void done(const Unit&) const {}
};

__device__ __forceinline__ unsigned cvt_pk_bf16(float lo, float hi) { unsigned r; asm volatile("v_cvt_pk_bf16_f32 %0, %1, %2" : "=v"(r) : "v"(lo), "v"(hi)); return r; }
typedef float f32x2 __attribute__((ext_vector_type(2)));

constexpr float RSQ_SCALE = 16777216.0f, RSQ_INV = 1.0f / 16777216.0f;
__device__ __forceinline__ unsigned long long rsq_fix(float s) { return (unsigned long long)(s * RSQ_SCALE + 0.5f); }
__device__ __forceinline__ float rstd_of(const unsigned long long* rsq, int row, float inv_n, float eps) {
    const unsigned long long v = rsq[row]; return __builtin_amdgcn_rsqf((float)v * (RSQ_INV * inv_n) + eps); }
__device__ __forceinline__ float fast_sigmoid(float v) { return __builtin_amdgcn_rcpf(1.0f + __builtin_amdgcn_exp2f(v * -1.44269504089f)); }
__device__ __forceinline__ float fast_silu(float v) { return v * fast_sigmoid(v); }
__device__ __forceinline__ u32x4 pack8(const f32x4 a, const f32x4 b) { u32x4 w; w.x = cvt_pk_bf16(a[0], a[1]); w.y = cvt_pk_bf16(a[2], a[3]); w.z = cvt_pk_bf16(b[0], b[1]); w.w = cvt_pk_bf16(b[2], b[3]); return w; }
__device__ __forceinline__ void unpack8(const u32x4 w, f32x4& a, f32x4& b) {
    a[0] = __uint_as_float(w.x << 16); a[1] = __uint_as_float(w.x & 0xffff0000u); a[2] = __uint_as_float(w.y << 16); a[3] = __uint_as_float(w.y & 0xffff0000u);
    b[0] = __uint_as_float(w.z << 16); b[1] = __uint_as_float(w.z & 0xffff0000u); b[2] = __uint_as_float(w.w << 16); b[3] = __uint_as_float(w.w & 0xffff0000u); }
constexpr float RMS_EPS_F = 1e-5f;

struct EpiGateUp {
    static constexpr bool PERM = true, AFTER_DRAIN = false;
    bf16_t* O; int ldc; const unsigned long long* rsq; float inv_n;
    __device__ __forceinline__ void operator()(const f32x4 (&acc)[2][2][4][2], const Unit& u, int wr, int wc, int fr, int fq) const {
        const int row0 = u.pm * BM + wr * 64 + fr, col0 = u.pn * HALF + wc * 32 + 8 * fq;
#pragma unroll
        for (int ai = 0; ai < 2; ++ai)
#pragma unroll
            for (int m = 0; m < 4; ++m) { const int row = row0 + ai * HALF + m * 16; const float rs = rstd_of(rsq, row, inv_n, RMS_EPS_F);
                f32x4 o[2];
#pragma unroll
                for (int n = 0; n < 2; ++n)
#pragma unroll
                    for (int j = 0; j < 4; ++j) o[n][j] = fast_silu(acc[ai][0][m][n][j] * rs) * (acc[ai][1][m][n][j] * rs);
                *(u32x4*)(O + (size_t)row * ldc + col0) = pack8(o[0], o[1]); }
    }
};
template <bool WITH_HB> struct EpiResid {
    static constexpr bool PERM = true, AFTER_DRAIN = false;
    const float* base; float* out; bf16_t* hb; unsigned long long* rsq_out; float scale; int ldc;
    __device__ __forceinline__ void operator()(const f32x4 (&acc)[2][2][4][2], const Unit& u, int wr, int wc, int fr, int fq) const {
        const int row0 = u.pm * BM + wr * 64 + fr, col0 = u.pn * BM + wc * 32 + 8 * fq;
#pragma unroll
        for (int ai = 0; ai < 2; ++ai)
#pragma unroll
            for (int m = 0; m < 4; ++m) { const int row = row0 + ai * HALF + m * 16; const size_t off = (size_t)row * ldc + col0; float ss = 0.f;
#pragma unroll
                for (int bj = 0; bj < 2; ++bj) {
                    const f32x4 b0 = *(const f32x4*)(base + off + bj * HALF), b1 = *(const f32x4*)(base + off + bj * HALF + 4);
                    const f32x4 v0 = b0 + acc[ai][bj][m][0] * scale, v1 = b1 + acc[ai][bj][m][1] * scale;
                    *(f32x4*)(out + off + bj * HALF) = v0; *(f32x4*)(out + off + bj * HALF + 4) = v1;
                    if (WITH_HB) *(u32x4*)(hb + off + bj * HALF) = pack8(v0, v1);
                    ss += (v0[0] * v0[0] + v0[1] * v0[1]) + (v0[2] * v0[2] + v0[3] * v0[3]) + (v1[0] * v1[0] + v1[1] * v1[1]) + (v1[2] * v1[2] + v1[3] * v1[3]); }
                ss += __shfl_xor(ss, 16); ss += __shfl_xor(ss, 32);
                if (fq == 0) atomicAdd(rsq_out + row, rsq_fix(ss));
                if (m == 3) asm volatile("" ::: "memory"); }
    }
};
struct EpiProj {
    static constexpr bool PERM = true, AFTER_DRAIN = false;
    bf16_t *CB, *U, *Z, *XBC, *GA, *GB; const float* gbias; const unsigned long long* rsq; float inv_n;
    template <int ACT  >
    __device__ __forceinline__ void plain(const f32x4 (&acc)[2][2][4][2], bf16_t* O, int ldc, int colt, const float* bias, int row0, int wc, int fq) const {
        const int col0 = colt + wc * 32 + 8 * fq;
        f32x4 bv[2][2];
#pragma unroll
        for (int bj = 0; bj < 2; ++bj)
#pragma unroll
            for (int n = 0; n < 2; ++n) bv[bj][n] = (ACT == 2) ? *(const f32x4*)(bias + col0 + bj * HALF + 4 * n) : (f32x4){0.f, 0.f, 0.f, 0.f};
#pragma unroll
        for (int ai = 0; ai < 2; ++ai)
#pragma unroll
            for (int m = 0; m < 4; ++m) { const int row = row0 + ai * HALF + m * 16; const float rs = rstd_of(rsq, row, inv_n, RMS_EPS_F);
#pragma unroll
                for (int bj = 0; bj < 2; ++bj) { f32x4 o[2];
#pragma unroll
                    for (int n = 0; n < 2; ++n)
#pragma unroll
                        for (int j = 0; j < 4; ++j) { const float v = acc[ai][bj][m][n][j] * rs; o[n][j] = (ACT == 0) ? v : (ACT == 1) ? fast_silu(v) : fast_sigmoid(v + bv[bj][n][j]); }
                    *(u32x4*)(O + (size_t)row * ldc + col0 + bj * HALF) = pack8(o[0], o[1]); } }
    }
    __device__ __forceinline__ void operator()(const f32x4 (&acc)[2][2][4][2], const Unit& u, int wr, int wc, int fr, int fq) const {
        const int row0 = u.pm * BM + wr * 64 + fr, pn = u.pn;
        if (pn < 16) plain<0>(acc, CB, 4096, pn * BM, nullptr, row0, wc, fq);
        else if (pn < 48) {
            const int col0 = (pn - 16) * HALF + wc * 32 + 8 * fq;
#pragma unroll
            for (int ai = 0; ai < 2; ++ai)
#pragma unroll
                for (int m = 0; m < 4; ++m) { const int row = row0 + ai * HALF + m * 16; const float rs = rstd_of(rsq, row, inv_n, RMS_EPS_F); const float rs2 = rs * rs;
                    f32x4 o[2];
#pragma unroll
                    for (int n = 0; n < 2; ++n) o[n] = (acc[ai][0][m][n] * acc[ai][1][m][n]) * rs2;
                    *(u32x4*)(U + (size_t)row * 4096 + col0) = pack8(o[0], o[1]); }
        }
        else if (pn < 80) plain<1>(acc, Z, 8192, (pn - 48) * BM, nullptr, row0, wc, fq);
        else if (pn < 120) plain<0>(acc, XBC, 10240, (pn - 80) * BM, nullptr, row0, wc, fq);
        else if (pn < 136) plain<2>(acc, GA, 4096, (pn - 120) * BM, gbias, row0, wc, fq);
        else plain<2>(acc, GB, 4096, (pn - 136) * BM, gbias + 4096, row0, wc, fq);
    }
};
struct EpiDtPart {
    static constexpr bool PERM = true, AFTER_DRAIN = false;
    float* P;
    __device__ __forceinline__ void operator()(const f32x4 (&acc)[2][2][4][2], const Unit& u, int wr, int wc, int fr, int fq) const {
        const int row0 = u.pm * BM + wr * 64 + fr, col0 = wc * 32 + 8 * fq;
#pragma unroll
        for (int ai = 0; ai < 2; ++ai)
#pragma unroll
            for (int m = 0; m < 4; ++m) { float* p = P + (size_t)(row0 + ai * HALF + m * 16) * 128 + col0; *(f32x4*)p = acc[ai][0][m][0]; *(f32x4*)(p + 4) = acc[ai][0][m][1]; }
    }
};
struct ProbeOrder : StaticOrder {
    __device__ __forceinline__ bool next(int i, Unit& u) const { const bool r = StaticOrder::next(i, u); u.pm = 0; u.pn = 0; return r; }
};
struct OneUnit {
    int pm;
    __device__ __forceinline__ bool next(int i, Unit& u) const { if (i != 0) return false; u.pm = pm; u.pn = 0; return true; }
    __device__ __forceinline__ void a_ready(const Unit&) const {}
    __device__ __forceinline__ void done(const Unit&) const {}
};
struct EpiScA {
    static constexpr bool PERM = true, AFTER_DRAIN = false;
    const bf16_t* GA; float* T;
    __device__ __forceinline__ void operator()(const f32x4 (&acc)[2][2][4][2], const Unit& u, int wr, int wc, int fr, int fq) const {
        const int row0 = u.pm * BM + wr * 64 + fr, col0 = u.pn * BM + wc * 32 + 8 * fq;
#pragma unroll
        for (int ai = 0; ai < 2; ++ai)
#pragma unroll
            for (int m = 0; m < 4; ++m) { const size_t off = (size_t)(row0 + ai * HALF + m * 16) * 4096 + col0;
#pragma unroll
                for (int bj = 0; bj < 2; ++bj) { f32x4 g0, g1; unpack8(*(const u32x4*)(GA + off + bj * HALF), g0, g1);
                    *(f32x4*)(T + off + bj * HALF) = g0 * acc[ai][bj][m][0]; *(f32x4*)(T + off + bj * HALF + 4) = g1 * acc[ai][bj][m][1]; }
                if (m == 3) asm volatile("" ::: "memory"); }
    }
};
struct EpiSsB {
    static constexpr bool PERM = true, AFTER_DRAIN = false;
    const bf16_t* GB; const float* T; bf16_t* MIX;
    __device__ __forceinline__ void operator()(const f32x4 (&acc)[2][2][4][2], const Unit& u, int wr, int wc, int fr, int fq) const {
        const int row0 = u.pm * BM + wr * 64 + fr, col0 = u.pn * BM + wc * 32 + 8 * fq;
#pragma unroll
        for (int ai = 0; ai < 2; ++ai)
#pragma unroll
            for (int m = 0; m < 4; ++m) { const size_t off = (size_t)(row0 + ai * HALF + m * 16) * 4096 + col0;
#pragma unroll
                for (int bj = 0; bj < 2; ++bj) { f32x4 g0, g1; unpack8(*(const u32x4*)(GB + off + bj * HALF), g0, g1);
                    const f32x4 t0 = *(const f32x4*)(T + off + bj * HALF), t1 = *(const f32x4*)(T + off + bj * HALF + 4);
                    *(u32x4*)(MIX + off + bj * HALF) = pack8(t0 + g0 * acc[ai][bj][m][0], t1 + g1 * acc[ai][bj][m][1]); }
                if (m == 3) asm volatile("" ::: "memory"); }
    }
};


template <class Epi, class Sched, bool ALIGN_EPI = false, bool SP2 = false>
__device__ __forceinline__ void gemm_phase(PG8_LAS unsigned char* lds, const Gemm g, const Sched& S, const Epi& E) {
    const int tid = threadIdx.x, wid = __builtin_amdgcn_readfirstlane(tid >> 6), lane = tid & 63, wr = wid >> 2, wc = wid & 3, fr = lane & 15, fq = lane >> 4;
    const int K = g.ld, nt = g.K / BK;
    unsigned voffA[2], voffB[2];
#pragma unroll
    for (int i = 0; i < 2; ++i) { int R, C; stage_rc(tid * 16 + i * 8192, R, C); const int Rb = Epi::PERM ? ((R & ~31) + perm32(R & 31)) : R;
        voffA[i] = (unsigned)(R * K + C) * 2u; voffB[i] = (unsigned)(Rb * K + C) * 2u; }
    const size_t kstep = (size_t)(BK * 2);
    const size_t hstep = (size_t)HALF * K * 2;
    const size_t tstep = 2 * hstep;
    const unsigned ldsw = (unsigned)wid * 1024u;
    const int aoff = lds_byte(wr * 64 + fr, fq * 8), boff = lds_byte(wc * 32 + fr, fq * 8);
#define PG8_SA(b, h) (((b) * 2 + (h)) * HTB)
#define PG8_SB(b, h) ((4 + (b) * 2 + (h)) * HTB)
#define PG8_STAGE(bufoff, gbase, voff) do { _Pragma("unroll") for (int _i = 0; _i < 2; ++_i) \
        __builtin_amdgcn_global_load_lds((const unsigned*)((const char*)(gbase) + (voff)[_i]), (PG8_LAS unsigned*)(lds + (bufoff) + ldsw + _i * 8192), 16, 0, 0); } while (0)
#define PG8_LDA(dst, b, h) do { _Pragma("unroll") for (int m = 0; m < 4; ++m) _Pragma("unroll") for (int k = 0; k < 2; ++k) dst[m][k] = *(const PG8_LAS bf16x8*)(lds + PG8_SA(b, h) + aoff + m * 2048 + k * 1024); } while (0)
#define PG8_LDB(dst, b, h) do { _Pragma("unroll") for (int n = 0; n < 2; ++n) _Pragma("unroll") for (int k = 0; k < 2; ++k) dst[n][k] = *(const PG8_LAS bf16x8*)(lds + PG8_SB(b, h) + boff + n * 2048 + k * 1024); } while (0)
#define PG8_MMA(ai, bj, At, Bt) do { __builtin_amdgcn_s_setprio(1); _Pragma("unroll") for (int m = 0; m < 4; ++m) _Pragma("unroll") for (int n = 0; n < 2; ++n) _Pragma("unroll") for (int k = 0; k < 2; ++k) \
        acc[ai][bj][m][n] = __builtin_amdgcn_mfma_f32_16x16x32_bf16(Bt[n][k], At[m][k], acc[ai][bj][m][n], 0, 0, 0); __builtin_amdgcn_s_setprio(0); } while (0)
#define PG8_WAIT_V(n) asm volatile("s_waitcnt vmcnt(" #n ")" ::: "memory")
#define PG8_WAIT_L(n) asm volatile("s_waitcnt lgkmcnt(" #n ")" ::: "memory")
#define PG8_BAR __builtin_amdgcn_s_barrier()
#define PG8_SCHED __builtin_amdgcn_sched_barrier(0)
    Unit cur, nxt; int ui = 0;
    if (!S.next(0, cur)) return;
    f32x4 acc[2][2][4][2];
#pragma unroll
    for (int a = 0; a < 2; ++a)
#pragma unroll
        for (int b = 0; b < 2; ++b)
#pragma unroll
            for (int m = 0; m < 4; ++m)
#pragma unroll
                for (int n = 0; n < 2; ++n) acc[a][b][m][n] = (f32x4){0.f, 0.f, 0.f, 0.f};
    bf16x8 At[4][2], B0[2][2], B1[2][2];
    const char* cA = (const char*)g.A + (size_t)cur.pm * tstep; const char* cB = (const char*)g.Bt + (size_t)cur.pn * tstep;
    S.a_ready(cur);
    if constexpr (SP2) {
        PG8_STAGE(PG8_SB(0, 0), cB, voffB); PG8_STAGE(PG8_SB(0, 1), cB + hstep, voffB); PG8_STAGE(PG8_SA(0, 0), cA, voffA); PG8_STAGE(PG8_SA(0, 1), cA + hstep, voffA);
        if (wr == 1) PG8_BAR;
        PG8_WAIT_V(2); PG8_BAR;
        PG8_STAGE(PG8_SB(1, 0), cB + kstep, voffB); PG8_STAGE(PG8_SA(1, 0), cA + kstep, voffA); PG8_STAGE(PG8_SB(1, 1), cB + hstep + kstep, voffB);
        PG8_WAIT_V(6); PG8_BAR;
    } else {
        PG8_STAGE(PG8_SB(0, 0), cB, voffB); PG8_STAGE(PG8_SA(0, 0), cA, voffA); PG8_STAGE(PG8_SB(0, 1), cB + hstep, voffB); PG8_STAGE(PG8_SA(0, 1), cA + hstep, voffA);
        if (wr == 1) PG8_BAR;
        PG8_WAIT_V(4); PG8_BAR;
        PG8_STAGE(PG8_SB(1, 0), cB + kstep, voffB); PG8_STAGE(PG8_SA(1, 0), cA + kstep, voffA); PG8_STAGE(PG8_SB(1, 1), cB + hstep + kstep, voffB);
        PG8_WAIT_V(6); PG8_BAR;
    }
    for (;;) {
        const bool has_next = S.next(ui + 1, nxt);
        const char* nA = has_next ? (const char*)g.A + (size_t)nxt.pm * tstep : cA; const char* nB = has_next ? (const char*)g.Bt + (size_t)nxt.pn * tstep : cB;
        for (int t = 0; t < nt; t += 2) {
            const bool last = (t == nt - 2);
            const char* a1 = cA + (size_t)(t + 1) * kstep;
            const char* a2 = last ? nA : cA + (size_t)(t + 2) * kstep; const char* b2 = last ? nB : cB + (size_t)(t + 2) * kstep;
            const char* a3 = a2 + kstep; const char* b3 = b2 + kstep;
            if (last && has_next) S.a_ready(nxt);
            if constexpr (SP2) {
            PG8_LDB(B0, 0, 0); PG8_LDB(B1, 0, 1); PG8_SCHED; PG8_LDA(At, 0, 0); PG8_STAGE(PG8_SA(1, 1), a1 + hstep, voffA);
            PG8_WAIT_V(8); PG8_WAIT_L(0); PG8_BAR; PG8_MMA(0, 0, At, B0); PG8_MMA(0, 1, At, B1); PG8_BAR; PG8_SCHED;
            PG8_LDA(At, 0, 1); PG8_STAGE(PG8_SB(0, 0), b2, voffB); PG8_STAGE(PG8_SB(0, 1), b2 + hstep, voffB); PG8_STAGE(PG8_SA(0, 0), a2, voffA);
            PG8_WAIT_V(8); PG8_WAIT_L(0); PG8_BAR; PG8_MMA(1, 0, At, B0); PG8_MMA(1, 1, At, B1); PG8_BAR; PG8_SCHED;
            PG8_LDB(B0, 1, 0); PG8_LDB(B1, 1, 1); PG8_SCHED; PG8_LDA(At, 1, 0); PG8_STAGE(PG8_SA(0, 1), a2 + hstep, voffA);
            PG8_WAIT_V(8); PG8_WAIT_L(0); PG8_BAR; PG8_MMA(0, 0, At, B0); PG8_MMA(0, 1, At, B1); PG8_BAR; PG8_SCHED;
            PG8_LDA(At, 1, 1); PG8_STAGE(PG8_SB(1, 0), b3, voffB); PG8_STAGE(PG8_SB(1, 1), b3 + hstep, voffB); PG8_STAGE(PG8_SA(1, 0), a3, voffA);
            PG8_WAIT_V(8); PG8_WAIT_L(0); PG8_BAR; PG8_MMA(1, 0, At, B0); PG8_MMA(1, 1, At, B1); PG8_BAR; PG8_SCHED;
            } else {
            PG8_LDB(B0, 0, 0); PG8_SCHED; PG8_LDA(At, 0, 0); PG8_STAGE(PG8_SA(1, 1), a1 + hstep, voffA);
            PG8_WAIT_L(8); PG8_BAR; PG8_WAIT_L(0); PG8_MMA(0, 0, At, B0); PG8_BAR; PG8_SCHED;
            PG8_LDB(B1, 0, 1); PG8_STAGE(PG8_SB(0, 0), b2, voffB);
            PG8_BAR; PG8_WAIT_L(0); PG8_MMA(0, 1, At, B1); PG8_BAR;
            PG8_LDA(At, 0, 1); PG8_STAGE(PG8_SA(0, 0), a2, voffA);
            PG8_BAR; PG8_WAIT_L(0); PG8_MMA(1, 0, At, B0); PG8_BAR; PG8_SCHED;
            PG8_STAGE(PG8_SB(0, 1), b2 + hstep, voffB);
            PG8_WAIT_V(6); PG8_BAR; PG8_MMA(1, 1, At, B1); PG8_BAR;
            PG8_LDB(B0, 1, 0); PG8_SCHED; PG8_LDA(At, 1, 0); PG8_STAGE(PG8_SA(0, 1), a2 + hstep, voffA);
            PG8_WAIT_L(8); PG8_BAR; PG8_WAIT_L(0); PG8_MMA(0, 0, At, B0); PG8_BAR; PG8_SCHED;
            PG8_LDB(B1, 1, 1); PG8_STAGE(PG8_SB(1, 0), b3, voffB);
            PG8_BAR; PG8_WAIT_L(0); PG8_MMA(0, 1, At, B1); PG8_BAR;
            PG8_LDA(At, 1, 1); PG8_STAGE(PG8_SA(1, 0), a3, voffA);
            PG8_BAR; PG8_WAIT_L(0); PG8_MMA(1, 0, At, B0); PG8_BAR; PG8_SCHED;
            PG8_STAGE(PG8_SB(1, 1), b3 + hstep, voffB);
            PG8_WAIT_V(6); PG8_BAR; PG8_MMA(1, 1, At, B1); PG8_BAR;
            }
        }
        if constexpr (ALIGN_EPI) { if (wr == 0) PG8_BAR; }
        if constexpr (!Epi::AFTER_DRAIN) { E(acc, cur, wr, wc, fr, fq); S.done(cur); }
        if (!has_next) break;
#pragma unroll
        for (int a = 0; a < 2; ++a)
#pragma unroll
            for (int b = 0; b < 2; ++b)
#pragma unroll
                for (int m = 0; m < 4; ++m)
#pragma unroll
                    for (int n = 0; n < 2; ++n) acc[a][b][m][n] = (f32x4){0.f, 0.f, 0.f, 0.f};
        cur = nxt; cA = nA; cB = nB; ++ui;
        if constexpr (ALIGN_EPI) { if (wr == 1) PG8_BAR; }
    }
    PG8_WAIT_V(0);
    if constexpr (!ALIGN_EPI) { if (wr == 0) PG8_BAR; }
    PG8_BAR;
    if constexpr (Epi::AFTER_DRAIN) { E.fused(acc, cur, wr, wc, fr, fq, lds, wid, lane); S.done(cur); }
#undef PG8_SA
#undef PG8_SB
#undef PG8_STAGE
#undef PG8_LDA
#undef PG8_LDB
#undef PG8_MMA
#undef PG8_WAIT_V
#undef PG8_WAIT_L
#undef PG8_BAR
#undef PG8_SCHED
}
}

constexpr int NWAVES = 8;
#ifndef MK_N_LAUNCHES
#define MK_N_LAUNCHES 1
#endif
#ifndef USE_CG_SYNC
#define USE_CG_SYNC 1
#endif
#ifndef PROBE_DUP
#define PROBE_DUP -1
#endif
#ifndef SSD_MFMA
#define SSD_MFMA 1
#endif
#ifndef XB_EVERY_WG_RELEASE
#define XB_EVERY_WG_RELEASE 1
#endif
#ifndef PG8_SP2
#define PG8_SP2 true
#endif
#ifndef PG8_ALIGN
#define PG8_ALIGN true
#endif
#ifndef PROBE_SYNCS
#define PROBE_SYNCS 0
#endif
#ifndef XB_LOGICAL_GROUPS
#define XB_LOGICAL_GROUPS 1
#endif
constexpr int NPHASE = 12;
constexpr int N_LAUNCHES = MK_N_LAUNCHES;
static_assert(N_LAUNCHES == 1, "one launch only: phase 4 has a grid sync inside");
constexpr int BATCH = 4, SEQ = 2048, D = 4096, FF = 11008, DI = 8192, NH = 128, CONVDIM = 10240;
constexpr int M = BATCH * SEQ;
constexpr int NPROJ = 39040, NPROJ_MAIN = 38912, NPROJ_PAD = 39168;
constexpr int DT_KS = 8;

constexpr size_t MiB = 1u << 20;
constexpr size_t WS_CTL = 0, CTL_ZERO_BYTES = 2 * MiB;
constexpr size_t WS_RSQ = 1 * MiB;
constexpr size_t WS_WGU1 = 2 * MiB, WS_WD1 = WS_WGU1 + 172 * MiB, WS_WIN = WS_WD1 + 86 * MiB, WS_WSC = WS_WIN + 306 * MiB, WS_WSS = WS_WSC + 32 * MiB,
                 WS_WO = WS_WSS + 64 * MiB, WS_WGU2 = WS_WO + 32 * MiB, WS_WD2 = WS_WGU2 + 172 * MiB;
constexpr size_t WS_H = WS_WD2 + 86 * MiB, WS_ACT = WS_H + 64 * MiB, WS_CB = WS_ACT + 172 * MiB, WS_U = WS_CB + 64 * MiB, WS_Z = WS_U + 64 * MiB, WS_XBC = WS_Z + 128 * MiB,
                 WS_GA = WS_XBC + 160 * MiB, WS_GB = WS_GA + 64 * MiB, WS_DT = WS_GB + 64 * MiB, WS_AIN = WS_DT + 4 * MiB, WS_YG = WS_AIN + 64 * MiB, WS_T = WS_YG + 128 * MiB,
                 WS_MIX = WS_T + 128 * MiB, WS_YN = WS_MIX + 64 * MiB, WS_DTP = WS_YN + 128 * MiB, WS_BCC = WS_DTP + 32 * MiB, WS_END = WS_BCC + 32 * MiB;
static_assert((size_t)2 * FF * D * 2 == 172 * MiB && (size_t)D * FF * 2 == 86 * MiB && (size_t)NPROJ_PAD * D * 2 == 306 * MiB && (size_t)M * FF * 2 == 172 * MiB && (size_t)M * CONVDIM * 2 == 160 * MiB, "d_ws map");
static_assert(WS_RSQ + (size_t)4 * M * 8 + (size_t)M * 8 * 8 <= CTL_ZERO_BYTES, "row statistics inside the memset region");
static_assert(WS_END <= (size_t)2440 * MiB, "d_ws map exceeds 4 x the largest input");
constexpr int CW_BAR = 4096;

constexpr int RING_OFF = 0, RING_BYTES = 131072;
constexpr int LDS_BYTES = 163840;
constexpr int LDSCTL_OFF = LDS_BYTES - 1024, MISC_OFF = LDSCTL_OFF + 320;
constexpr int SSD_DD_OFF = RING_BYTES + 1024;
static_assert(MISC_OFF + 128 <= LDS_BYTES && SSD_DD_OFF + 1024 <= LDSCTL_OFF, "LDS map");

#define GAS __attribute__((address_space(1)))
#define LAS __attribute__((address_space(3)))
typedef unsigned short bf16;
typedef unsigned v4u __attribute__((ext_vector_type(4)));
typedef float f32x4 __attribute__((ext_vector_type(4)));
typedef short bf16x8 __attribute__((ext_vector_type(8)));
typedef GAS unsigned gu32;
typedef GAS unsigned long long gu64;
#define RLX_AGENT __ATOMIC_RELAXED, __HIP_MEMORY_SCOPE_AGENT
#define LDS_WAIT() asm volatile("s_waitcnt lgkmcnt(0)" ::: "memory")
#define VM_WAIT() asm volatile("s_waitcnt vmcnt(0)" ::: "memory")
__device__ __forceinline__ unsigned long long rt() { return __builtin_amdgcn_s_memrealtime(); }
__device__ __forceinline__ unsigned f2bf(float f) { unsigned u = __builtin_bit_cast(unsigned, f); return (u + 0x7fffu + ((u >> 16) & 1u)) >> 16; }
__device__ __forceinline__ unsigned pk2(float lo, float hi) { return f2bf(lo) | (f2bf(hi) << 16); }
#define XB_TMO      128
#define XB_XCNT(j)  (256  + 64 * (j))
#define XB_XSUB(j)  (1280 + 64 * (j))
#define XB_XGEN(j)  (2304 + 64 * (j))
#define XB_TOP      3328
#define XB_TOPGEN   3392
#define XCD_BAR_WORDS 3456
#define XB_SPIN_CAP (1u << 18)

__device__ __forceinline__ unsigned xb_ld(unsigned* p)              { return __hip_atomic_load(p, __ATOMIC_RELAXED, __HIP_MEMORY_SCOPE_AGENT); }
__device__ __forceinline__ unsigned xb_add(unsigned* p, unsigned v) { return __hip_atomic_fetch_add(p, v, __ATOMIC_RELAXED, __HIP_MEMORY_SCOPE_AGENT); }
#if XB_LOGICAL_GROUPS
__device__ __forceinline__ unsigned xb_xcc_id() { return blockIdx.x & 7u; }
#else
__device__ __forceinline__ unsigned xb_xcc_id() { return (unsigned)__builtin_amdgcn_s_getreg((3 << 11) | 20) & 0xFu; }
#endif
#define XB_SPIN(cond, bar) do { unsigned _sp = 0; while (cond) { __builtin_amdgcn_s_sleep(1); \
    if ((++_sp & 255u) == 0u) { if (xb_ld(&(bar)[XB_TMO])) break; if (_sp > XB_SPIN_CAP) { atomicAdd(&(bar)[XB_TMO], 1u); break; } } } } while (0)

struct XcdBarrier {
    unsigned* bar; unsigned x;
    volatile LAS unsigned* st;
};

__device__ __forceinline__ XcdBarrier xcd_barrier_post(unsigned* bar, volatile LAS unsigned* st) {
    XcdBarrier b; b.bar = bar; b.x = xb_xcc_id(); b.st = st;
    if (threadIdx.x == 0) (void)xb_add(&bar[XB_XCNT(b.x)], 1u);
    return b;
}
__device__ __forceinline__ void xcd_barrier_complete(unsigned* bar, unsigned x, unsigned& nloc, unsigned& nx) {
    const unsigned G = gridDim.x * gridDim.y * gridDim.z;
    unsigned sum, cnt, mine, sp = 0u;
    for (;;) {
        sum = 0u; cnt = 0u; mine = 0u;
#pragma unroll
        for (unsigned j = 0; j < 16; ++j) { const unsigned c = xb_ld(&bar[XB_XCNT(j)]); sum += c; cnt += (c > 0u) ? 1u : 0u; mine = (j == x) ? c : mine; }
        if (sum == G) break;
        __builtin_amdgcn_s_sleep(1);
        if ((++sp & 255u) == 0u) { if (xb_ld(&bar[XB_TMO])) break; if (sp > XB_SPIN_CAP) { atomicAdd(&bar[XB_TMO], 1u); break; } }
    }
    nloc = mine > 0u ? mine : 1u; nx = cnt > 0u ? cnt : 1u;
}

__device__ __forceinline__ void xcd_barrier(const XcdBarrier& b) {
    asm volatile("s_waitcnt vmcnt(0)" ::: "memory");
    __syncthreads();
    if (threadIdx.x == 0) {
        unsigned* bar = b.bar;
        __builtin_amdgcn_s_waitcnt(0);
        unsigned nloc = b.st[0], nx = b.st[1];
        if (nloc == 0u) { xcd_barrier_complete(bar, b.x, nloc, nx); b.st[0] = nloc; b.st[1] = nx; }
#if XB_EVERY_WG_RELEASE
        __builtin_amdgcn_fence(__ATOMIC_RELEASE, "agent"); asm volatile("s_waitcnt vmcnt(0)" ::: "memory");
#endif
        const unsigned old = xb_add(&bar[XB_XSUB(b.x)], 1u);
        const unsigned gen = old / nloc;
        if (old + 1u == (gen + 1u) * nloc) {
            __builtin_amdgcn_fence(__ATOMIC_RELEASE, "agent");
            asm volatile("s_waitcnt vmcnt(0)" ::: "memory");
            const unsigned og = xb_add(&bar[XB_TOP], 1u);
            const unsigned tg = og / nx;
            if (og + 1u == (tg + 1u) * nx) xb_add(&bar[XB_TOPGEN], 1u);
            else XB_SPIN(xb_ld(&bar[XB_TOPGEN]) == tg, bar);
            __builtin_amdgcn_fence(__ATOMIC_ACQUIRE, "agent");
            xb_add(&bar[XB_XGEN(b.x)], 1u);
            asm volatile("s_waitcnt vmcnt(0)" ::: "memory");
        } else {
            XB_SPIN(xb_ld(&bar[XB_XGEN(b.x)]) == gen, bar);
            __builtin_amdgcn_fence(__ATOMIC_ACQUIRE, "agent");
            asm volatile("s_waitcnt vmcnt(0)" ::: "memory");
        }
    }
    __syncthreads();
}

struct Frame {
    LAS unsigned char* lds;
    volatile LAS unsigned* MISC;
    gu32* ctl;
    int tid, lane, wave;
    int vcu, G;
};
__device__ __forceinline__ float wave_sum(float v) {
#pragma unroll
    for (int o = 1; o < 64; o <<= 1) v += __shfl_xor(v, o);
    return v;
}
typedef short v4i16_t __attribute__((ext_vector_type(4)));
__device__ __forceinline__ v4i16_t lds_tr(const LAS unsigned char* p) { return __builtin_amdgcn_ds_read_tr16_b64_v4i16((LAS v4i16_t*)p); }
__device__ __forceinline__ float bf_lo(unsigned w) { return __uint_as_float(w << 16); }
__device__ __forceinline__ float bf_hi(unsigned w) { return __uint_as_float(w & 0xffff0000u); }

__device__ __forceinline__ void p0_transpose_item(const float* W, int ld, int c0, int K, bf16* WT, int drow0, const float* nw, LAS float* scr, int kb, int lane) {
    const int k0 = 64 * kb, r = lane >> 4, c4 = lane & 15;
    f32x4 v[16];
    const float* src = W + (size_t)(k0 + r) * ld + c0 + 4 * c4;
#pragma unroll
    for (int i = 0; i < 16; ++i) v[i] = *(const GAS f32x4*)(src + (size_t)(4 * i) * ld);
    if (nw) {
#pragma unroll
        for (int i = 0; i < 16; ++i) v[i] = v[i] * nw[k0 + 4 * i + r];
    }
#pragma unroll
    for (int i = 0; i < 16; ++i) { const int k = 4 * i + r; *(LAS f32x4*)(scr + k * 64 + ((4 * c4) ^ (8 * (k >> 3)))) = v[i]; }
    LDS_WAIT(); asm volatile("" ::: "memory");
    const int c = lane >> 3, nl = lane & 7;
#pragma unroll
    for (int j = 0; j < 8; ++j) { const int n = nl + 8 * j; const LAS float* s = scr + (8 * c) * 64 + (n ^ (8 * c));
        v4u o; o.x = pg8::cvt_pk_bf16(s[0 * 64], s[1 * 64]); o.y = pg8::cvt_pk_bf16(s[2 * 64], s[3 * 64]); o.z = pg8::cvt_pk_bf16(s[4 * 64], s[5 * 64]); o.w = pg8::cvt_pk_bf16(s[6 * 64], s[7 * 64]);
        *(GAS v4u*)(WT + (size_t)(drow0 + n) * K + k0 + 8 * c) = o; }
    LDS_WAIT(); asm volatile("" ::: "memory");
}
struct Job { int in, ld, src0, ncols, K, dst0, il, nw; size_t wt; };

struct Args { const float* in[23]; float* out; unsigned char* ws; int ph_lo, ph_hi; };

__device__ __forceinline__ Job get_job(int j) {
    switch (j) {
    case 0:  return Job{2, FF, 0, FF, D, 0, 1, 1, WS_WGU1};
    case 1:  return Job{3, FF, 0, FF, D, 0, 2, 1, WS_WGU1};
    case 2:  return Job{4, D, 0, D, FF, 0, 0, -1, WS_WD1};
    case 3:  return Job{6, NPROJ, 0, 4096, D, 0, 0, 5, WS_WIN};
    case 4:  return Job{6, NPROJ, 4096, 4096, D, 4096, 1, 5, WS_WIN};
    case 5:  return Job{6, NPROJ, 8192, 4096, D, 4096, 2, 5, WS_WIN};
    case 6:  return Job{6, NPROJ, 12288, 8192, D, 12288, 0, 5, WS_WIN};
    case 7:  return Job{6, NPROJ, 20480, 10240, D, 20480, 0, 5, WS_WIN};
    case 8:  return Job{6, NPROJ, 30848, 4096, D, 30720, 0, 5, WS_WIN};
    case 9:  return Job{6, NPROJ, 34944, 4096, D, 34816, 0, 5, WS_WIN};
    case 10: return Job{6, NPROJ, 30720, 128, D, 38912, 0, 5, WS_WIN};
    case 11: return Job{9, D, 0, D, D, 0, 0, -1, WS_WSC};
    case 12: return Job{16, D, 0, D, DI, 0, 0, 15, WS_WSS};
    case 13: return Job{17, D, 0, D, D, 0, 0, -1, WS_WO};
    case 14: return Job{19, FF, 0, FF, D, 0, 1, 18, WS_WGU2};
    case 15: return Job{20, FF, 0, FF, D, 0, 2, 18, WS_WGU2};
    default: return Job{21, D, 0, D, FF, 0, 0, -1, WS_WD2};
    }
}
constexpr int NJOBS = 17;
__host__ __device__ constexpr long job_items(int ncols, int K) { return (long)(K / 64) * (ncols / 64); }

__global__ void __launch_bounds__(NWAVES * 64, 2) hyb_fwd(Args args) {
    extern __shared__ __attribute__((aligned(16))) unsigned char lds[];
    Frame F;
    F.lds = (LAS unsigned char*)lds;
    F.MISC = (volatile LAS unsigned*)(F.lds + MISC_OFF);
    F.tid = threadIdx.x; F.lane = F.tid & 63; F.wave = __builtin_amdgcn_readfirstlane(F.tid >> 6);
    F.G = gridDim.x; { const int bx = blockIdx.x; F.vcu = (F.G % 8 == 0) ? (bx % 8) * (F.G / 8) + bx / 8 : bx; }
    unsigned char* ws = args.ws;
    F.ctl = (gu32*)(ws + WS_CTL);
    for (int u = F.tid; u < (LDS_BYTES - LDSCTL_OFF) / 4; u += NWAVES * 64) ((LAS unsigned*)(F.lds + LDSCTL_OFF))[u] = 0u;
    __syncthreads();
    XcdBarrier bar; bar.bar = (unsigned*)(F.ctl + CW_BAR); bar.x = 0; bar.st = nullptr;
    if (N_LAUNCHES == 1 && USE_CG_SYNC != 1) bar = xcd_barrier_post((unsigned*)(F.ctl + CW_BAR), F.MISC + 8);
#if USE_CG_SYNC == 1
#define GRID_BAR() do { if (N_LAUNCHES == 1) cooperative_groups::this_grid().sync(); } while (0)
#else
#define GRID_BAR() do { if (N_LAUNCHES == 1) xcd_barrier(bar); } while (0)
#endif
#if USE_CG_SYNC == 2
    if (N_LAUNCHES == 1) cooperative_groups::this_grid().sync();
#endif
    const int lo = args.ph_lo, hi = args.ph_hi;
#define IN(k) (lo <= (k) && (k) < hi)
#define BOTH(k) (IN(k) && IN((k) + 1))
    const float* x_in = args.in[0];
    float* xres = args.out;
    bf16* Hb = (bf16*)(ws + WS_H); bf16* ACT = (bf16*)(ws + WS_ACT);
    bf16* CBb = (bf16*)(ws + WS_CB); bf16* Ub = (bf16*)(ws + WS_U); bf16* Zb = (bf16*)(ws + WS_Z); bf16* XBCb = (bf16*)(ws + WS_XBC);
    bf16* GAb = (bf16*)(ws + WS_GA); bf16* GBb = (bf16*)(ws + WS_GB); const float* DTP = (const float*)(ws + WS_DTP);
    bf16* AIN = (bf16*)(ws + WS_AIN); bf16* YG = (bf16*)(ws + WS_YG); float* Tb = (float*)(ws + WS_T); bf16* MIX = (bf16*)(ws + WS_MIX); bf16* YN = (bf16*)(ws + WS_YN); bf16* BCC = (bf16*)(ws + WS_BCC);
    unsigned long long* RSQ1 = (unsigned long long*)(ws + WS_RSQ); unsigned long long* RSQ2 = RSQ1 + M; unsigned long long* RSQ3 = RSQ2 + M; unsigned long long* RSQ4 = RSQ3 + M;
    unsigned long long* GSQ = RSQ4 + M;
    const int gw = F.vcu * NWAVES + F.wave, NGW = F.G * NWAVES;

    if (IN(0)) for (int prep_ = 0; prep_ < (PROBE_DUP == 0 ? 2 : 1); ++prep_) {
        if (prep_) __syncthreads();
        LAS float* scr = (LAS float*)(F.lds + RING_OFF + F.wave * 16384);
        long base = 0;
        for (int j = 0; j < NJOBS; ++j) {
            const Job jb = get_job(j); const int nblk = jb.ncols / 64; const long nit = job_items(jb.ncols, jb.K);
            const float* W = args.in[jb.in]; const float* nw = jb.nw >= 0 ? args.in[jb.nw] : nullptr; bf16* WT = (bf16*)(ws + jb.wt);
            long first = (long)gw - (base % NGW); if (first < 0) first += NGW;
            for (long it = first; it < nit; it += NGW) {
                const int kb = (int)(it / nblk), nb = (int)(it % nblk), c = 64 * nb;
                const int drow = jb.il == 0 ? jb.dst0 + c : jb.dst0 + (c >> 7) * 256 + (c & 127) + (jb.il == 2 ? 128 : 0);
                p0_transpose_item(W, jb.ld, jb.src0 + c, jb.K, WT, drow, nw, scr, kb, F.lane);
            }
            base += nit;
        }
        {
            v4u* z = (v4u*)((bf16*)(ws + WS_WIN) + (size_t)39040 * D); const size_t n16 = (size_t)128 * D * 2 / 16;
            for (size_t i = (size_t)blockIdx.x * (NWAVES * 64) + F.tid; i < n16; i += (size_t)F.G * NWAVES * 64) z[i] = (v4u){0u, 0u, 0u, 0u};
        }
        for (int m = gw; m < M; m += NGW) {
            const GAS f32x4* xr = (const GAS f32x4*)(x_in + (size_t)m * D) + F.lane; GAS unsigned long long* o8 = (GAS unsigned long long*)(Hb + (size_t)m * D) + F.lane; float s = 0.f;
#pragma unroll
            for (int j = 0; j < 16; ++j) { const f32x4 v = xr[64 * j]; s += (v.x * v.x + v.y * v.y) + (v.z * v.z + v.w * v.w);
                o8[64 * j] = (unsigned long long)pg8::cvt_pk_bf16(v.x, v.y) | ((unsigned long long)pg8::cvt_pk_bf16(v.z, v.w) << 32); }
            s = wave_sum(s);
            if (F.lane == 0) RSQ1[m] = pg8::rsq_fix(s);
        }
    }
    if (BOTH(0)) GRID_BAR();
    if (IN(1)) {
        pg8::Gemm g{Hb, (const bf16*)(ws + WS_WGU1), M, 2 * FF, D, D}; pg8::StaticOrder S; S.init(M, 2 * FF, F.G, (int)blockIdx.x);
        pg8::EpiGateUp E{ACT, FF, RSQ1, 1.0f / D};
        pg8::gemm_phase<pg8::EpiGateUp, pg8::StaticOrder, PG8_ALIGN, PG8_SP2>(F.lds + RING_OFF, g, S, E);
    }
#if PROBE_DUP == 1
    if (IN(1)) {
        pg8::Gemm g{Hb, (const bf16*)(ws + WS_WGU1), M, 2 * FF, D, D}; pg8::StaticOrder S; S.init(M, 2 * FF, F.G, (int)blockIdx.x);
        pg8::EpiGateUp E{ACT, FF, RSQ1, 1.0f / D};
        pg8::gemm_phase<pg8::EpiGateUp, pg8::StaticOrder, PG8_ALIGN, PG8_SP2>(F.lds + RING_OFF, g, S, E);
    }
#endif
#if PROBE_DUP == 101
    if (IN(1)) {
        pg8::Gemm g{Hb, (const bf16*)(ws + WS_WGU1), M, 2 * FF, D, D}; pg8::ProbeOrder S; S.init(M, 2 * FF, F.G, (int)blockIdx.x);
        pg8::EpiGateUp E{(bf16*)(ws + WS_T), FF, RSQ1, 1.0f / D};
        pg8::gemm_phase<pg8::EpiGateUp, pg8::ProbeOrder, PG8_ALIGN, PG8_SP2>(F.lds + RING_OFF, g, S, E);
    }
#endif
    if (BOTH(1)) GRID_BAR();
    if (IN(2)) {
        pg8::Gemm g{ACT, (const bf16*)(ws + WS_WD1), M, D, FF, FF}; pg8::StaticOrder S; S.init(M, D, F.G, (int)blockIdx.x);
        pg8::EpiResid<true> E{x_in, xres, Hb, RSQ2, 0.5f, D};
        pg8::gemm_phase<pg8::EpiResid<true>, pg8::StaticOrder, PG8_ALIGN, PG8_SP2>(F.lds + RING_OFF, g, S, E);
    }
#if PROBE_DUP == 2
    if (IN(2)) {
        pg8::Gemm g{ACT, (const bf16*)(ws + WS_WD1), M, D, FF, FF}; pg8::StaticOrder S; S.init(M, D, F.G, (int)blockIdx.x);
        pg8::EpiResid<true> E{x_in, xres, Hb, (unsigned long long*)(ws + WS_T), 0.5f, D};
        pg8::gemm_phase<pg8::EpiResid<true>, pg8::StaticOrder, PG8_ALIGN, PG8_SP2>(F.lds + RING_OFF, g, S, E);
    }
#endif
    if (IN(2)) {
        if (BOTH(2)) GRID_BAR();
    }
    if (IN(3)) {
        pg8::Gemm g{Hb, (const bf16*)(ws + WS_WIN), M, NPROJ_MAIN, D, D}; pg8::StaticOrder S; S.init(M, NPROJ_MAIN, F.G, (int)blockIdx.x);
        pg8::EpiProj E{CBb, Ub, Zb, XBCb, GAb, GBb, args.in[7], RSQ2, 1.0f / D};
        pg8::gemm_phase<pg8::EpiProj, pg8::StaticOrder, PG8_ALIGN, PG8_SP2>(F.lds + RING_OFF, g, S, E);
        {
            const int item = (int)blockIdx.x, pm = item & 31, ks = item >> 5;
            if (item < 32 * DT_KS) {
                pg8::Gemm gd{Hb + ks * (D / DT_KS), (const bf16*)(ws + WS_WIN) + (size_t)NPROJ_MAIN * D + ks * (D / DT_KS), M, 256, D / DT_KS, D}; pg8::OneUnit S1{pm};
                pg8::EpiDtPart E1{(float*)(ws + WS_DTP) + (size_t)ks * M * 128};
                pg8::gemm_phase<pg8::EpiDtPart, pg8::OneUnit, false, PG8_SP2>(F.lds + RING_OFF, gd, S1, E1);
            }
        }
        if (BOTH(3)) GRID_BAR();
    }
    if (IN(4)) for (int prep_ = 0; prep_ < (PROBE_DUP == 4 ? 2 : 1); ++prep_) {
        unsigned long long* GSQw = prep_ ? (unsigned long long*)(ws + WS_T) : GSQ;
        {
            const float* cw = args.in[8]; const int c8 = F.tid * 8;
            float w0[8], w1[8], w2[8];
#pragma unroll
            for (int i = 0; i < 8; ++i) { w0[i] = cw[c8 + i]; w1[i] = cw[4096 + c8 + i]; w2[i] = cw[8192 + c8 + i]; }
            for (int strip = blockIdx.x; strip < M / 32; strip += F.G) {
                const int r0 = strip * 32; v4u um2 = (v4u){0u, 0u, 0u, 0u}, um1 = um2;
                if ((r0 % SEQ) != 0) { um2 = *(const v4u*)(Ub + (size_t)(r0 - 2) * 4096 + c8); um1 = *(const v4u*)(Ub + (size_t)(r0 - 1) * 4096 + c8); }
#pragma unroll 4
                for (int r = r0; r < r0 + 32; ++r) {
                    const v4u u0 = *(const v4u*)(Ub + (size_t)r * 4096 + c8), cb = *(const v4u*)(CBb + (size_t)r * 4096 + c8);
                    const unsigned a[4] = {um2.x, um2.y, um2.z, um2.w}, b[4] = {um1.x, um1.y, um1.z, um1.w}, c[4] = {u0.x, u0.y, u0.z, u0.w}, d[4] = {cb.x, cb.y, cb.z, cb.w};
                    unsigned o[4];
#pragma unroll
                    for (int q = 0; q < 4; ++q) {
                        const float lo_ = bf_lo(d[q]) * (w0[2 * q] * bf_lo(a[q]) + w1[2 * q] * bf_lo(b[q]) + w2[2 * q] * bf_lo(c[q]));
                        const float hi_ = bf_hi(d[q]) * (w0[2 * q + 1] * bf_hi(a[q]) + w1[2 * q + 1] * bf_hi(b[q]) + w2[2 * q + 1] * bf_hi(c[q]));
                        o[q] = pg8::cvt_pk_bf16(lo_, hi_); }
                    *(v4u*)(AIN + (size_t)r * 4096 + c8) = (v4u){o[0], o[1], o[2], o[3]};
                    um2 = um1; um1 = u0;
                }
            }
        }
        {
            const float* convw = args.in[10]; const float* convb = args.in[11];
            const int cgp = F.tid & 255, rh = F.tid >> 8, col = DI + cgp * 8;
            float cw[4][8], cbias[8];
#pragma unroll
            for (int k = 0; k < 4; ++k)
#pragma unroll
                for (int i = 0; i < 8; ++i) cw[k][i] = convw[k * CONVDIM + col + i];
#pragma unroll
            for (int i = 0; i < 8; ++i) cbias[i] = convb[col + i];
            for (int strip = blockIdx.x; strip < M / 32; strip += F.G) {
                const int r0 = strip * 32 + rh * 16;
                v4u h0 = (v4u){0u, 0u, 0u, 0u}, h1 = h0, h2 = h0;
                if ((r0 % SEQ) != 0) { h0 = *(const v4u*)(XBCb + (size_t)(r0 - 3) * CONVDIM + col); h1 = *(const v4u*)(XBCb + (size_t)(r0 - 2) * CONVDIM + col); h2 = *(const v4u*)(XBCb + (size_t)(r0 - 1) * CONVDIM + col); }
#pragma unroll 4
                for (int r = r0; r < r0 + 16; ++r) {
                    const v4u cur = *(const v4u*)(XBCb + (size_t)r * CONVDIM + col);
                    const unsigned a[4] = {h0.x, h0.y, h0.z, h0.w}, b[4] = {h1.x, h1.y, h1.z, h1.w}, c[4] = {h2.x, h2.y, h2.z, h2.w}, d[4] = {cur.x, cur.y, cur.z, cur.w};
                    float o[8];
#pragma unroll
                    for (int q = 0; q < 4; ++q) {
                        o[2 * q] = cbias[2 * q] + cw[0][2 * q] * bf_lo(a[q]) + cw[1][2 * q] * bf_lo(b[q]) + cw[2][2 * q] * bf_lo(c[q]) + cw[3][2 * q] * bf_lo(d[q]);
                        o[2 * q + 1] = cbias[2 * q + 1] + cw[0][2 * q + 1] * bf_hi(a[q]) + cw[1][2 * q + 1] * bf_hi(b[q]) + cw[2][2 * q + 1] * bf_hi(c[q]) + cw[3][2 * q + 1] * bf_hi(d[q]); }
#pragma unroll
                    for (int i = 0; i < 8; ++i) o[i] = pg8::fast_silu(o[i]);
                    *(v4u*)(BCC + (size_t)r * 2048 + cgp * 8) = pg8::pack8((pg8::f32x4){o[0], o[1], o[2], o[3]}, (pg8::f32x4){o[4], o[5], o[6], o[7]});
                    h0 = h1; h1 = h2; h2 = cur;
                }
            }
        }
        GRID_BAR();
        {
            constexpr int P = 272, PX = 144, YP = 68;
            constexpr int C_OFF = 0, B_OFF = 128 * P, X_OFF = 2 * 128 * P, PS_OFF = X_OFF + 128 * PX, F_OFF = PS_OFF + 64 * P, Y_OFF = F_OFF + 2048, CW_OFF = Y_OFF + 128 * YP * 4, DTA_OFF = CW_OFF + 5 * 320 * 4;
            static_assert(Y_OFF % 16 == 0 && CW_OFF % 16 == 0 && DTA_OFF + SEQ * 4 <= LDSCTL_OFF, "SSD LDS map");
            LAS unsigned char* const L = F.lds;
            LAS float* const dt_s = (LAS float*)(L + F_OFF); LAS float* const acs_s = dt_s + 128; LAS float* const wd_s = dt_s + 256;
            LAS float* const Ys = (LAS float*)(L + Y_OFF);
            LAS float* const dtall = (LAS float*)(L + DTA_OFF);
            LAS float* const cwl = (LAS float*)(L + CW_OFF);
            const float* convw = args.in[10]; const float* convb = args.in[11];
            const int w = F.wave;
            const int cg = F.tid & 31, ts = F.tid >> 5;
            const int xcg = F.tid & 7, xts = F.tid >> 3;
            for (int unit = blockIdx.x; unit < BATCH * NH; unit += F.G) {
                const int b = unit / NH, h = unit % NH, g = h >> 4;
                const float Ah = -__expf(args.in[13][h]), Dh = args.in[14][h];
                const int bc_col = cg < 16 ? g * 128 + cg * 8 : 1024 + g * 128 + (cg - 16) * 8;
                const int x_col = h * 64 + xcg * 8;
                const int bc_l = cg < 16 ? cg * 8 : 128 + (cg - 16) * 8, x_l = 256 + xcg * 8;
                __syncthreads();
                for (int i = F.tid; i < 5 * 320; i += NWAVES * 64) { const int k = i / 320, c = i % 320;
                    const int col = c < 128 ? DI + g * 128 + c : c < 256 ? DI + 1024 + g * 128 + (c - 128) : h * 64 + (c - 256);
                    cwl[i] = k < 4 ? convw[k * CONVDIM + col] : convb[col]; }
                for (int i = F.tid; i < SEQ; i += NWAVES * 64) { const size_t row = (size_t)b * SEQ + i; float sacc = 0.f;
#pragma unroll
                    for (int ks = 0; ks < DT_KS; ++ks) sacc += DTP[((size_t)ks * M + row) * 128 + h];
                    const float v = sacc * pg8::rstd_of(RSQ2, (int)row, 1.0f / D, pg8::RMS_EPS_F) + args.in[12][h];
                    dtall[i] = fmaxf(v, 0.f) + log1pf(__expf(-fabsf(v))); }
                pg8::f32x4 Sacc[4];
#pragma unroll
                for (int t = 0; t < 4; ++t) Sacc[t] = (pg8::f32x4){0.f, 0.f, 0.f, 0.f};
                for (int i = F.tid; i < 64 * P / 16; i += NWAVES * 64) ((LAS v4u*)(L + PS_OFF))[i] = (v4u){0u, 0u, 0u, 0u};
                v4u rawA[8], rawX[5];
#define SSD_LOAD_RAW(T0) do { \
    _Pragma("unroll") for (int j = 0; j < 8; ++j) rawA[j] = *(const v4u*)(BCC + ((size_t)b * SEQ + (T0) + ts * 8 + j) * 2048 + bc_col); \
    _Pragma("unroll") for (int j = 0; j < 5; ++j) { const int tl = (T0) + xts * 2 - 3 + j; \
        rawX[j] = tl >= 0 ? *(const v4u*)(XBCb + ((size_t)b * SEQ + tl) * CONVDIM + x_col) : (v4u){0u, 0u, 0u, 0u}; } } while (0)
                SSD_LOAD_RAW(0);
                for (int ch = 0; ch < SEQ / 128; ++ch) {
                    const int t0 = ch * 128; const size_t row0 = (size_t)b * SEQ + t0;
                    int l = F.lane; asm volatile("" : "+v"(l));
                    const int g4 = l >> 4, li = l & 15, q4 = li >> 2, p4 = li & 3;
                    __syncthreads();
                    {
                        {
                            LAS unsigned char* dst = L + (cg < 16 ? B_OFF + cg * 16 : C_OFF + (cg - 16) * 16);
#pragma unroll
                            for (int r = 0; r < 8; ++r) *(LAS v4u*)(dst + (ts * 8 + r) * P) = rawA[r];
                        }
                        {
                            float cw[4][8], cbias[8];
#pragma unroll
                            for (int k = 0; k < 4; ++k) { const pg8::f32x4 u0 = *(const LAS pg8::f32x4*)(cwl + k * 320 + x_l), u1 = *(const LAS pg8::f32x4*)(cwl + k * 320 + x_l + 4);
#pragma unroll
                                for (int i = 0; i < 4; ++i) { cw[k][i] = u0[i]; cw[k][4 + i] = u1[i]; } }
                            { const pg8::f32x4 u0 = *(const LAS pg8::f32x4*)(cwl + 4 * 320 + x_l), u1 = *(const LAS pg8::f32x4*)(cwl + 4 * 320 + x_l + 4);
#pragma unroll
                                for (int i = 0; i < 4; ++i) { cbias[i] = u0[i]; cbias[4 + i] = u1[i]; } }
                            LAS unsigned char* xdst = L + X_OFF + xcg * 16;
#pragma unroll
                            for (int r = 0; r < 2; ++r) { float o[8];
#pragma unroll
                                for (int i = 0; i < 8; ++i) o[i] = cbias[i];
#pragma unroll
                                for (int k = 0; k < 4; ++k) { const v4u ww_ = rawX[r + k]; const unsigned ww[4] = {ww_.x, ww_.y, ww_.z, ww_.w};
#pragma unroll
                                    for (int q = 0; q < 4; ++q) { o[2 * q] += cw[k][2 * q] * bf_lo(ww[q]); o[2 * q + 1] += cw[k][2 * q + 1] * bf_hi(ww[q]); } }
#pragma unroll
                                for (int i = 0; i < 8; ++i) o[i] = pg8::fast_silu(o[i]);
                                *(LAS v4u*)(xdst + (xts * 2 + r) * PX) = pg8::pack8((pg8::f32x4){o[0], o[1], o[2], o[3]}, (pg8::f32x4){o[4], o[5], o[6], o[7]}); }
                        }
                        if (F.tid >= 128 && F.tid < 256) {
                            const float d_lo = dtall[t0 + l], d_hi = dtall[t0 + 64 + l];
                            const float a_lo = d_lo * Ah, a_hi = d_hi * Ah;
                            const float tot_lo = wave_sum(a_lo), tot = tot_lo + wave_sum(a_hi);
                            const bool hiw = (w == 3);
                            float v = hiw ? a_hi : a_lo;
#pragma unroll
                            for (int d = 1; d < 64; d <<= 1) { const float u = __shfl_up(v, d); if (l >= d) v += u; }
                            if (hiw) v += tot_lo;
                            const int t = F.tid - 128; const float dtv = hiw ? d_hi : d_lo;
                            dt_s[t] = dtv; acs_s[t] = v; wd_s[t] = dtv * __expf(tot - v);
                        }
                    }
                    __syncthreads();
                    if (ch + 1 < SEQ / 128) SSD_LOAD_RAW(t0 + 128);
                    const size_t zrow = row0 + (F.tid >> 2);
                    const v4u z0 = *(const v4u*)(Zb + zrow * DI + h * 64 + (F.tid & 3) * 16), z1 = *(const v4u*)(Zb + zrow * DI + h * 64 + (F.tid & 3) * 16 + 8);
                    pg8::bf16x8 Cf[4];
#pragma unroll
                    for (int ks = 0; ks < 4; ++ks) Cf[ks] = *(const LAS pg8::bf16x8*)(L + C_OFF + (16 * w + li) * P + (32 * ks + 8 * g4) * 2);
                    const float acs_i = acs_s[16 * w + li];
                    pg8::f32x4 yd[4], yo[4];
#pragma unroll
                    for (int pt = 0; pt < 4; ++pt) { yd[pt] = (pg8::f32x4){0.f, 0.f, 0.f, 0.f}; yo[pt] = (pg8::f32x4){0.f, 0.f, 0.f, 0.f}; }
#pragma unroll
                    for (int k2 = 0; k2 < 4; ++k2) {
                        if (2 * k2 <= w) {
                            pg8::f32x4 sv[2];
#pragma unroll
                            for (int u = 0; u < 2; ++u) {
                                const int jt = 2 * k2 + u;
                                sv[u] = (pg8::f32x4){0.f, 0.f, 0.f, 0.f};
                                if (jt <= w) {
                                    pg8::f32x4 cb = (pg8::f32x4){0.f, 0.f, 0.f, 0.f};
#pragma unroll
                                    for (int ks = 0; ks < 4; ++ks) { const pg8::bf16x8 bf = *(const LAS pg8::bf16x8*)(L + B_OFF + (16 * jt + li) * P + (32 * ks + 8 * g4) * 2);
                                        cb = __builtin_amdgcn_mfma_f32_16x16x32_bf16(bf, Cf[ks], cb, 0, 0, 0); }
                                    const pg8::f32x4 aj = *(const LAS pg8::f32x4*)(acs_s + 16 * jt + 4 * g4), dj = *(const LAS pg8::f32x4*)(dt_s + 16 * jt + 4 * g4);
#pragma unroll
                                    for (int r = 0; r < 4; ++r) { const bool ok = (jt < w) || (4 * g4 + r <= li); const float e = ok ? __expf(acs_i - aj[r]) : 0.f; sv[u][r] = cb[r] * e * dj[r]; }
                                }
                            }
                            const pg8::bf16x8 Sf = __builtin_bit_cast(pg8::bf16x8, pg8::pack8(sv[0], sv[1]));
#pragma unroll
                            for (int pt = 0; pt < 4; ++pt) {
                                const LAS unsigned char* xa = L + X_OFF + (32 * k2 + 4 * g4 + q4) * PX + (16 * pt + 4 * p4) * 2;
                                const pg8::bf16x8 Xf = __builtin_shufflevector(lds_tr(xa), lds_tr(xa + 16 * PX), 0, 1, 2, 3, 4, 5, 6, 7);
                                yd[pt] = __builtin_amdgcn_mfma_f32_16x16x32_bf16(Sf, Xf, yd[pt], 0, 0, 0); }
                        }
                    }
#pragma unroll
                    for (int pt = 0; pt < 4; ++pt)
#pragma unroll
                        for (int ks = 0; ks < 4; ++ks) { const pg8::bf16x8 pf = *(const LAS pg8::bf16x8*)(L + PS_OFF + (16 * pt + li) * P + (32 * ks + 8 * g4) * 2);
                            yo[pt] = __builtin_amdgcn_mfma_f32_16x16x32_bf16(Cf[ks], pf, yo[pt], 0, 0, 0); }
                    {
                        const pg8::f32x4 ai = *(const LAS pg8::f32x4*)(acs_s + 16 * w + 4 * g4);
#pragma unroll
                        for (int r = 0; r < 4; ++r) { const float ei = __expf(ai[r]);
#pragma unroll
                            for (int pt = 0; pt < 4; ++pt) Ys[(16 * w + 4 * g4 + r) * YP + 16 * pt + li] = yd[pt][r] + ei * yo[pt][r]; }
                    }
                    {
                        const float dec = __expf(acs_s[127]); const int spt = w & 3, snt0 = 4 * (w >> 2);
#pragma unroll
                        for (int t = 0; t < 4; ++t) Sacc[t] = Sacc[t] * dec;
#pragma unroll
                        for (int ks = 0; ks < 4; ++ks) {
                            const LAS unsigned char* xa = L + X_OFF + (32 * ks + 8 * g4 + q4) * PX + (16 * spt + 4 * p4) * 2;
                            const pg8::u32x4 xr = __builtin_bit_cast(pg8::u32x4, (pg8::bf16x8)__builtin_shufflevector(lds_tr(xa), lds_tr(xa + 4 * PX), 0, 1, 2, 3, 4, 5, 6, 7));
                            pg8::f32x4 xl, xh; pg8::unpack8(xr, xl, xh);
                            const pg8::f32x4 wl = *(const LAS pg8::f32x4*)(wd_s + 32 * ks + 8 * g4), wh = *(const LAS pg8::f32x4*)(wd_s + 32 * ks + 8 * g4 + 4);
                            const pg8::bf16x8 Xw = __builtin_bit_cast(pg8::bf16x8, pg8::pack8(xl * wl, xh * wh));
#pragma unroll
                            for (int t = 0; t < 4; ++t) {
                                const LAS unsigned char* ba = L + B_OFF + (32 * ks + 8 * g4 + q4) * P + (16 * (snt0 + t) + 4 * p4) * 2;
                                const pg8::bf16x8 Bf = __builtin_shufflevector(lds_tr(ba), lds_tr(ba + 4 * P), 0, 1, 2, 3, 4, 5, 6, 7);
                                Sacc[t] = __builtin_amdgcn_mfma_f32_16x16x32_bf16(Xw, Bf, Sacc[t], 0, 0, 0); }
                        }
                    }
                    __syncthreads();
                    {
                        const int spt = w & 3, snt0 = 4 * (w >> 2);
#pragma unroll
                        for (int t = 0; t < 4; ++t)
#pragma unroll
                            for (int r = 0; r < 4; ++r) *(LAS unsigned short*)(L + PS_OFF + (16 * spt + 4 * g4 + r) * P + (16 * (snt0 + t) + li) * 2) = (unsigned short)(pg8::cvt_pk_bf16(Sacc[t][r], 0.f) & 0xffffu);
                    }
                    {
                        const int row = F.tid >> 2, seg = F.tid & 3; const size_t grow = row0 + row;
                        const LAS pg8::f32x4* yp = (const LAS pg8::f32x4*)(Ys + row * YP + seg * 16);
                        const LAS v4u* xp = (const LAS v4u*)(L + X_OFF + row * PX + seg * 32);
                        pg8::f32x4 za, zb, zc, zd, xa_, xb_, xc_, xd_; pg8::unpack8(z0, za, zb); pg8::unpack8(z1, zc, zd); pg8::unpack8(xp[0], xa_, xb_); pg8::unpack8(xp[1], xc_, xd_);
                        const pg8::f32x4 v0 = (yp[0] + xa_ * Dh) * za, v1 = (yp[1] + xb_ * Dh) * zb, v2 = (yp[2] + xc_ * Dh) * zc, v3 = (yp[3] + xd_ * Dh) * zd;
                        float ss = 0.f;
#pragma unroll
                        for (int i = 0; i < 4; ++i) ss += (v0[i] * v0[i] + v1[i] * v1[i]) + (v2[i] * v2[i] + v3[i] * v3[i]);
                        *(v4u*)(YG + grow * DI + h * 64 + seg * 16) = pg8::pack8(v0, v1); *(v4u*)(YG + grow * DI + h * 64 + seg * 16 + 8) = pg8::pack8(v2, v3);
                        ss += __shfl_xor(ss, 1); ss += __shfl_xor(ss, 2);
                        if (seg == 0) atomicAdd(GSQw + grow * 8 + g, pg8::rsq_fix(ss));
                    }
                }
            }
        }
#undef SSD_LOAD_RAW
    }
    if (BOTH(4)) GRID_BAR();
    if (IN(5)) {
        for (int m = gw; m < M; m += NGW) {
            const GAS v4u* yr = (const GAS v4u*)(YG + (size_t)m * DI) + F.lane; GAS v4u* yo = (GAS v4u*)(YN + (size_t)m * DI) + F.lane;
#pragma unroll 4
            for (int j = 0; j < 16; ++j) { const float rs = pg8::rstd_of(GSQ, m * 8 + (j >> 1), 1.0f / 1024.0f, pg8::RMS_EPS_F);
                const v4u w = yr[64 * j]; f32x4 a, b2; pg8::unpack8(w, a, b2); yo[64 * j] = pg8::pack8(a * rs, b2 * rs); }
        }
    }
    if (IN(6)) {
        pg8::Gemm g{AIN, (const bf16*)(ws + WS_WSC), M, D, D, D}; pg8::StaticOrder S; S.init(M, D, F.G, (int)blockIdx.x);
        pg8::EpiScA E{GAb, Tb};
        pg8::gemm_phase<pg8::EpiScA, pg8::StaticOrder, PG8_ALIGN, PG8_SP2>(F.lds + RING_OFF, g, S, E);
        if (BOTH(6)) GRID_BAR();
    }
    if (IN(7)) {
        pg8::Gemm g{YN, (const bf16*)(ws + WS_WSS), M, D, DI, DI}; pg8::StaticOrder S; S.init(M, D, F.G, (int)blockIdx.x);
        pg8::EpiSsB E{GBb, Tb, MIX};
        pg8::gemm_phase<pg8::EpiSsB, pg8::StaticOrder, PG8_ALIGN, PG8_SP2>(F.lds + RING_OFF, g, S, E);
        if (BOTH(7)) GRID_BAR();
    }
    if (IN(8)) {
        pg8::Gemm g{MIX, (const bf16*)(ws + WS_WO), M, D, D, D}; pg8::StaticOrder S; S.init(M, D, F.G, (int)blockIdx.x);
        pg8::EpiResid<true> E{xres, xres, Hb, RSQ3, 1.0f, D};
        pg8::gemm_phase<pg8::EpiResid<true>, pg8::StaticOrder, PG8_ALIGN, PG8_SP2>(F.lds + RING_OFF, g, S, E);
        if (BOTH(8)) GRID_BAR();
    }
    if (IN(9)) {
        pg8::Gemm g{Hb, (const bf16*)(ws + WS_WGU2), M, 2 * FF, D, D}; pg8::StaticOrder S; S.init(M, 2 * FF, F.G, (int)blockIdx.x);
        pg8::EpiGateUp E{ACT, FF, RSQ3, 1.0f / D};
        pg8::gemm_phase<pg8::EpiGateUp, pg8::StaticOrder, PG8_ALIGN, PG8_SP2>(F.lds + RING_OFF, g, S, E);
        if (BOTH(9)) GRID_BAR();
    }
    if (IN(10)) {
        pg8::Gemm g{ACT, (const bf16*)(ws + WS_WD2), M, D, FF, FF}; pg8::StaticOrder S; S.init(M, D, F.G, (int)blockIdx.x);
        pg8::EpiResid<false> E{xres, xres, nullptr, RSQ4, 0.5f, D};
        pg8::gemm_phase<pg8::EpiResid<false>, pg8::StaticOrder, PG8_ALIGN, PG8_SP2>(F.lds + RING_OFF, g, S, E);
        if (BOTH(10)) GRID_BAR();
    }
#if PROBE_SYNCS
    for (int i_ = 0; i_ < PROBE_SYNCS; ++i_) GRID_BAR();
#endif
    if (IN(11)) {
        const float* fw = args.in[22];
        for (int m = gw; m < M; m += NGW) {
            const float rs = pg8::rstd_of(RSQ4, m, 1.0f / D, pg8::RMS_EPS_F);
            GAS f32x4* xr = (GAS f32x4*)(xres + (size_t)m * D) + F.lane; const f32x4* wr4 = (const f32x4*)fw + F.lane;
#pragma unroll 4
            for (int j = 0; j < 16; ++j) { const f32x4 v = xr[64 * j]; xr[64 * j] = v * rs * wr4[64 * j]; }
        }
    }
#undef IN
#undef BOTH
#undef GRID_BAR
}

extern "C" void kernel_launch(void* const* d_in, const int* in_sizes, int n_in, void* d_out, int out_size, void* d_ws, size_t ws_size, hipStream_t stream) {
    static int grid = 0;
    if (grid == 0) {
        if (n_in != 23 || in_sizes[0] != M * D || out_size != M * D || ws_size < WS_END) { fprintf(stderr, "kernel_launch: unexpected shapes / workspace (n_in %d, in0 %d, out %d, ws %zu, need %zu); nothing launched\n", n_in, n_in > 0 ? in_sizes[0] : -1, out_size, ws_size, (size_t)WS_END); grid = -1; return; }
        int dev = 0, cus = 0, per_cu = 0;
        if (hipGetDevice(&dev) != hipSuccess || hipDeviceGetAttribute(&cus, hipDeviceAttributeMultiprocessorCount, dev) != hipSuccess) { grid = -1; return; }
        if (hipFuncSetAttribute((const void*)hyb_fwd, hipFuncAttributeMaxDynamicSharedMemorySize, LDS_BYTES) != hipSuccess) { fprintf(stderr, "kernel_launch: hipFuncSetAttribute failed\n"); grid = -1; return; }
        if (hipOccupancyMaxActiveBlocksPerMultiprocessor(&per_cu, (const void*)hyb_fwd, NWAVES * 64, LDS_BYTES) != hipSuccess || per_cu < 1)
            fprintf(stderr, "kernel_launch: note: occupancy query reports %d workgroups per CU\n", per_cu);
        (void)hipGetLastError();
        if (cus != 256) { fprintf(stderr, "kernel_launch: built for a 256-CU device (got %d)\n", cus); grid = -1; return; }
        grid = cus;
    }
    if (grid < 0) return;
    if (hipMemsetAsync((char*)d_ws + WS_CTL, 0, CTL_ZERO_BYTES, stream) != hipSuccess) { fprintf(stderr, "kernel_launch: memset failed\n"); return; }
    Args a{};
    for (int i = 0; i < 23; ++i) a.in[i] = (const float*)d_in[i];
    a.out = (float*)d_out; a.ws = (unsigned char*)d_ws;
    for (int li = 0; li < N_LAUNCHES; ++li) {
        a.ph_lo = (N_LAUNCHES == 1) ? 0 : li; a.ph_hi = (N_LAUNCHES == 1) ? NPHASE : li + 1;
        hipError_t le;
        if (N_LAUNCHES == 1 && USE_CG_SYNC) { void* kargs[] = {(void*)&a}; le = hipLaunchCooperativeKernel((const void*)hyb_fwd, dim3(grid), dim3(NWAVES * 64), kargs, LDS_BYTES, stream); }
        else { hipLaunchKernelGGL(hyb_fwd, dim3(grid), dim3(NWAVES * 64), LDS_BYTES, stream, a); le = hipPeekAtLastError(); }
        if (le != hipSuccess) { fprintf(stderr, "kernel_launch: launch %d failed: %s\n", li, hipGetErrorName(le)); break; }
    }
}
```
